# Optimizing an MI355X kernel written in HIP

```python
import jax, jax.numpy as jnp
from jax import lax

D_MODEL = 1024
BATCH = 16
SEQ = 2048
DEPTH = 2

D_MIX = D_MODEL
CHUNK = 128
A_GROUPS = 4
A_WIDTH = D_MIX // 4
A_HEAD = A_WIDTH // A_GROUPS
B_GROUPS = 4
B_WIDTH = D_MIX // 4
CONV_W = 3
C_HEADS = 4
C_WIDTH = D_MIX // 2
C_HEAD = C_WIDTH // C_HEADS
ROPE_BASE = 10000.0
D_PROJ = 2 * A_WIDTH + 3 * B_WIDTH + 4 * C_WIDTH
D_FF = 2816
MACARON = 0.5
EPS = 1e-6

kernel_name = "hybrid_gmlp_shortconv_retention_macaron"


def _rmsnorm(x, g):
    xf = x.astype(jnp.float32)
    y = xf * lax.rsqrt(jnp.mean(xf * xf, axis=-1, keepdims=True) + EPS)
    return (y * g.astype(jnp.float32)).astype(x.dtype)


def _group_layernorm(x, g, groups):
    shp = x.shape
    xf = x.astype(jnp.float32).reshape(shp[:-1] + (groups, shp[-1] // groups))
    mu = jnp.mean(xf, axis=-1, keepdims=True)
    var = jnp.mean(jnp.square(xf - mu), axis=-1, keepdims=True)
    y = ((xf - mu) * lax.rsqrt(var + EPS)).reshape(shp)
    return (y * g.astype(jnp.float32)).astype(x.dtype)


def _swiglu(x, w_gate, w_up, w_down):
    return (jax.nn.silu(x @ w_gate) * (x @ w_up)) @ w_down


def _gmlp_mixer(p, v_norm, w_s, b_s):
    bsz, s, _ = p.shape
    nc = s // CHUNK
    z = jax.nn.gelu(p)
    u, v = z[..., :A_WIDTH], z[..., A_WIDTH:]
    v = _group_layernorm(v, v_norm, A_GROUPS)
    v = v.reshape(bsz, nc, CHUNK, A_GROUPS, A_HEAD)
    causal = jnp.tril(jnp.ones((CHUNK, CHUNK), dtype=w_s.dtype))
    ws = w_s * causal[None]
    sv = jnp.einsum('gts,bnsgd->bntgd', ws, v) + b_s.T[None, None, :, :, None]
    return u * sv.reshape(bsz, s, A_WIDTH)


def _shortconv_mixer(p, conv_w):
    s = p.shape[1]
    bg, cg, xin = p[..., :B_WIDTH], p[..., B_WIDTH:2 * B_WIDTH], p[..., 2 * B_WIDTH:]
    z = cg * xin
    zp = jnp.pad(z, ((0, 0), (CONV_W - 1, 0), (0, 0)))
    y = sum(zp[:, i:i + s, :] * conv_w[i] for i in range(CONV_W))
    return bg * y


def _rotary(x, pos):
    half = x.shape[-1] // 2
    inv = ROPE_BASE ** (-jnp.arange(half, dtype=jnp.float32) / half)
    ang = pos[:, None] * inv[None, :]
    cos = jnp.cos(ang)[None, :, None, :]
    sin = jnp.sin(ang)[None, :, None, :]
    x1, x2 = x[..., :half], x[..., half:]
    return jnp.concatenate([x1 * cos - x2 * sin, x2 * cos + x1 * sin], axis=-1)


def _retention_mixer(p, gn):
    dtype = p.dtype
    bsz, s, _ = p.shape
    nc = s // CHUNK
    pf = p.astype(jnp.float32)
    q = pf[..., 0 * C_WIDTH:1 * C_WIDTH].reshape(bsz, s, C_HEADS, C_HEAD)
    k = pf[..., 1 * C_WIDTH:2 * C_WIDTH].reshape(bsz, s, C_HEADS, C_HEAD)
    v = pf[..., 2 * C_WIDTH:3 * C_WIDTH].reshape(bsz, s, C_HEADS, C_HEAD)
    g = p[..., 3 * C_WIDTH:]
    pos = jnp.arange(s, dtype=jnp.float32)
    q = _rotary(q, pos)
    k = _rotary(k, pos) * (C_HEAD ** -0.5)

    log_g = jnp.log1p(-jnp.exp2(-5.0 - jnp.arange(C_HEADS, dtype=jnp.float32)))
    idx = jnp.arange(CHUNK, dtype=jnp.float32)
    diff = idx[:, None] - idx[None, :]
    decay = jnp.where(diff[None] >= 0,
                      jnp.exp(log_g[:, None, None] * jnp.maximum(diff, 0.0)[None]), 0.0)
    zeta = jnp.exp(log_g[None, :] * (CHUNK - 1 - idx)[:, None])
    xi = jnp.exp(log_g[None, :] * (idx + 1.0)[:, None])
    gamma_chunk = jnp.exp(log_g * CHUNK)

    qc = q.reshape(bsz, nc, CHUNK, C_HEADS, C_HEAD)
    kc = k.reshape(bsz, nc, CHUNK, C_HEADS, C_HEAD)
    vc = v.reshape(bsz, nc, CHUNK, C_HEADS, C_HEAD)

    scores = jnp.einsum('bnthd,bnshd->bnhts', qc, kc) * decay[None, None]
    inner = jnp.einsum('bnhts,bnshv->bnthv', scores, vc)

    chunk_kv = jnp.einsum('bnshd,sh,bnshv->bnhdv', kc, zeta, vc)

    def step(state, kv):
        return state * gamma_chunk[None, :, None, None] + kv, state

    init = jnp.zeros((bsz, C_HEADS, C_HEAD, C_HEAD), jnp.float32)
    _, prev = lax.scan(step, init, jnp.moveaxis(chunk_kv, 1, 0))
    cross = jnp.einsum('bnthd,nbhdv,th->bnthv', qc, prev, xi)

    ret = (inner + cross).reshape(bsz, s, C_WIDTH)
    ret = _group_layernorm(ret, gn, C_HEADS).astype(dtype)
    return jax.nn.silu(g) * ret


def _layer(x, ffn1_norm, ffn1_w_gate, ffn1_w_up, ffn1_w_down, mix_norm, w_in,
           gmlp_v_norm, gmlp_w_s, gmlp_b_s, conv_w, ret_gn, w_out,
           ffn2_norm, ffn2_w_gate, ffn2_w_up, ffn2_w_down):
    x = x + MACARON * _swiglu(_rmsnorm(x, ffn1_norm), ffn1_w_gate, ffn1_w_up, ffn1_w_down)
    h = _rmsnorm(x, mix_norm)
    p = h @ w_in
    a_end = 2 * A_WIDTH
    b_end = a_end + 3 * B_WIDTH
    y_a = _gmlp_mixer(p[..., :a_end], gmlp_v_norm, gmlp_w_s, gmlp_b_s)
    y_b = _shortconv_mixer(p[..., a_end:b_end], conv_w)
    y_c = _retention_mixer(p[..., b_end:], ret_gn)
    x = x + jnp.concatenate([y_a, y_b, y_c], axis=-1) @ w_out
    x = x + MACARON * _swiglu(_rmsnorm(x, ffn2_norm), ffn2_w_gate, ffn2_w_up, ffn2_w_down)
    return x


def setup_inputs(seed: int = 0) -> dict:
    key = jax.random.key(seed)
    ks = jax.random.split(key, 18)
    f32 = jnp.float32

    def w(k, shape, fan_in):
        return jax.random.normal(k, shape, f32) * (fan_in ** -0.5)

    def gain(k, shape):
        return 1.0 + 0.1 * jax.random.normal(k, shape, f32)

    return {
        "x": jax.random.normal(ks[0], (BATCH, SEQ, D_MODEL), f32),
        "ffn1_norm": gain(ks[1], (DEPTH, D_MODEL)),
        "ffn1_w_gate": w(ks[2], (DEPTH, D_MODEL, D_FF), D_MODEL),
        "ffn1_w_up": w(ks[3], (DEPTH, D_MODEL, D_FF), D_MODEL),
        "ffn1_w_down": w(ks[4], (DEPTH, D_FF, D_MODEL), D_FF),
        "mix_norm": gain(ks[5], (DEPTH, D_MODEL)),
        "w_in": w(ks[6], (DEPTH, D_MODEL, D_PROJ), D_MODEL),
        "gmlp_v_norm": gain(ks[7], (DEPTH, A_WIDTH)),
        "gmlp_w_s": w(ks[8], (DEPTH, A_GROUPS, CHUNK, CHUNK), CHUNK),
        "gmlp_b_s": 1.0 + 0.1 * jax.random.normal(ks[9], (DEPTH, A_GROUPS, CHUNK), f32),
        "conv_w": w(ks[10], (DEPTH, CONV_W, B_WIDTH), CONV_W),
        "ret_gn": gain(ks[11], (DEPTH, C_WIDTH)),
        "w_out": w(ks[12], (DEPTH, D_MIX, D_MODEL), D_MIX),
        "ffn2_norm": gain(ks[13], (DEPTH, D_MODEL)),
        "ffn2_w_gate": w(ks[14], (DEPTH, D_MODEL, D_FF), D_MODEL),
        "ffn2_w_up": w(ks[15], (DEPTH, D_MODEL, D_FF), D_MODEL),
        "ffn2_w_down": w(ks[16], (DEPTH, D_FF, D_MODEL), D_FF),
        "final_norm": gain(ks[17], (D_MODEL,)),
    }


def reference(x, ffn1_norm, ffn1_w_gate, ffn1_w_up, ffn1_w_down, mix_norm, w_in,
              gmlp_v_norm, gmlp_w_s, gmlp_b_s, conv_w, ret_gn, w_out,
              ffn2_norm, ffn2_w_gate, ffn2_w_up, ffn2_w_down, final_norm):
    for l in range(DEPTH):
        x = _layer(x, ffn1_norm[l], ffn1_w_gate[l], ffn1_w_up[l], ffn1_w_down[l],
                   mix_norm[l], w_in[l], gmlp_v_norm[l], gmlp_w_s[l], gmlp_b_s[l],
                   conv_w[l], ret_gn[l], w_out[l],
                   ffn2_norm[l], ffn2_w_gate[l], ffn2_w_up[l], ffn2_w_down[l])
    return _rmsnorm(x, final_norm)
```

```cpp
#include <hip/hip_runtime.h>
#include <cstdio>
#include <cstdint>
namespace pg8 {
#define PG8_LAS __attribute__((address_space(3)))
typedef unsigned short bf16_t;
typedef short bf16x8 __attribute__((ext_vector_type(8)));
typedef float f32x4 __attribute__((ext_vector_type(4)));
typedef unsigned u32x4 __attribute__((ext_vector_type(4)));
constexpr int BM = 256, BK = 64, HALF = 128, HTB = HALF * BK * 2  , STAGE_BYTES = 8 * HTB, NXCD = 8, WGM = 8;

__host__ __device__ __forceinline__ int lds_byte(int r, int c) { const int st = (r >> 4) * 2 + (c >> 5), rr = r & 15, cc = c & 31, ob = rr * 64 + cc * 2; return st * 1024 + (ob ^ (((ob >> 9) & 1) << 5)); }
__host__ __device__ __forceinline__ void stage_rc(int b, int& R, int& C) { const int st = b / 1024, sb = b % 1024, swz = sb ^ (((sb >> 9) & 1) << 5); R = (st >> 1) * 16 + swz / 64; C = (st & 1) * 32 + (swz % 64) / 2; }
__host__ __device__ __forceinline__ int perm32(int rho) { const int n = rho >> 4, i = rho & 15; return 8 * (i >> 2) + 4 * n + (i & 3); }

struct Unit { int pm, pn; };
struct Gemm { const bf16_t* A; const bf16_t* Bt; int M, N, K; };

struct StaticOrder {
    int nM, nN, nwg, G, c;
    __host__ __device__ void init(int M, int N, int G_, int c_) { nM = M / BM; nN = N / BM; nwg = nM * nN; G = G_; c = c_; }
    __host__ __device__ bool next(int i, Unit& u) const {
        const long L = (long)i * G + c; if (L >= nwg) return false;
        int wgid = (int)L; { const int q = nwg / NXCD, r = nwg % NXCD, xcd = wgid % NXCD, off = wgid / NXCD; wgid = (xcd < r ? xcd * (q + 1) : r * (q + 1) + (xcd - r) * q) + off; }
        const int nig = WGM * nN, gid = wgid / nig, fm = gid * WGM, gsz = (nM - fm) < WGM ? (nM - fm) : WGM;
        u.pm = fm + ((wgid % nig) % gsz); u.pn = (wgid % nig) / gsz; return true;
    }
    __device__ __forceinline__ void a_ready(const Unit&) const {}
    __device__ __forceinline__ void done(const Unit&) const {}
};

__device__ __forceinline__ unsigned cvt_pk_bf16(float lo, float hi) { unsigned r; asm volatile("v_cvt_pk_bf16_f32 %0, %1, %2" : "=v"(r) : "v"(lo), "v"(hi)); return r; }
typedef float f32x2 __attribute__((ext_vector_type(2)));
typedef float f32x2 __attribute__((ext_vector_type(2)));
__device__ __forceinline__ float fexp2(float x) { return __builtin_amdgcn_exp2f(x); }
__device__ __forceinline__ float frcp(float x) { return __builtin_amdgcn_rcpf(x); }
__device__ __forceinline__ float silu_f(float x) { return x * frcp(1.f + fexp2(-1.4426950408889634f * x)); }
__device__ __forceinline__ float gelu_f(float x) { const float u = x * (1.f + 0.044715f * x * x) * 2.302208198144325f; return x * frcp(1.f + fexp2(-u)); }
__device__ __forceinline__ float ld_sc1(const float* p) { return __hip_atomic_load(p, __ATOMIC_RELAXED, __HIP_MEMORY_SCOPE_AGENT); }
__device__ __forceinline__ float row_rstd(const float* ssq, int r) { return __builtin_amdgcn_rsqf(ld_sc1(ssq + r) * (1.0f / 1024.0f) + 1e-6f); }
__device__ __forceinline__ u32x4 pack8(const f32x4& a, const f32x4& b) { u32x4 w; w.x = cvt_pk_bf16(a[0], a[1]); w.y = cvt_pk_bf16(a[2], a[3]); w.z = cvt_pk_bf16(b[0], b[1]); w.w = cvt_pk_bf16(b[2], b[3]); return w; }

constexpr int DFF = 2816, DM = 1024, PW = 3072;

struct EpiSwiglu {
    static constexpr bool PERM = true, AFTER_DRAIN = false;
    bf16_t* H; const float* ssq;
    __device__ __forceinline__ void operator()(const f32x4 (&acc)[2][2][4][2], const Unit& u, int wr, int wc, int fr, int fq) const {
        const int row0 = u.pm * BM + wr * 64 + fr, col0 = u.pn * 128 + wc * 32 + 8 * fq;
        float rs[2][4];
#pragma unroll
        for (int ai = 0; ai < 2; ++ai)
#pragma unroll
            for (int m = 0; m < 4; ++m) rs[ai][m] = row_rstd(ssq, row0 + ai * HALF + m * 16);
#pragma unroll
        for (int ai = 0; ai < 2; ++ai)
#pragma unroll
            for (int m = 0; m < 4; ++m) {
                const float s = rs[ai][m]; f32x4 h0, h1;
#pragma unroll
                for (int e = 0; e < 4; ++e) { h0[e] = silu_f(acc[ai][0][m][0][e] * s) * (acc[ai][1][m][0][e] * s); h1[e] = silu_f(acc[ai][0][m][1][e] * s) * (acc[ai][1][m][1][e] * s); }
                *(u32x4*)(H + (size_t)(row0 + ai * HALF + m * 16) * DFF + col0) = pack8(h0, h1);
            }
    }
};

struct EpiResid {
    static constexpr bool PERM = true, AFTER_DRAIN = false;
    const float* base; float* X; bf16_t* XB; float* ssq_out;
    __device__ __forceinline__ void operator()(const f32x4 (&acc)[2][2][4][2], const Unit& u, int wr, int wc, int fr, int fq) const {
        const int row0 = u.pm * BM + wr * 64 + fr, col0 = u.pn * BM + wc * 32 + 8 * fq;
#pragma unroll
        for (int ai = 0; ai < 2; ++ai)
#pragma unroll
            for (int m = 0; m < 4; ++m) {
                const int r = row0 + ai * HALF + m * 16; const size_t off = (size_t)r * DM + col0; float s = 0.f;
#pragma unroll
                for (int bj = 0; bj < 2; ++bj) {
                    const f32x4 b0 = *(const f32x4*)(base + off + bj * HALF), b1 = *(const f32x4*)(base + off + bj * HALF + 4);
                    const f32x4 x0 = b0 + acc[ai][bj][m][0], x1 = b1 + acc[ai][bj][m][1];
                    *(f32x4*)(X + off + bj * HALF) = x0; *(f32x4*)(X + off + bj * HALF + 4) = x1;
                    *(u32x4*)(XB + off + bj * HALF) = pack8(x0, x1);
                    s += (x0[0] * x0[0] + x0[1] * x0[1]) + (x0[2] * x0[2] + x0[3] * x0[3]) + (x1[0] * x1[0] + x1[1] * x1[1]) + (x1[2] * x1[2] + x1[3] * x1[3]);
                }
                s += __shfl_xor(s, 16); s += __shfl_xor(s, 32);
                if (fq == 0) atomicAdd(ssq_out + r, s);
                if (m & 1) asm volatile("" ::: "memory");
            }
    }
};

struct EpiMix {
    static constexpr bool PERM = true, AFTER_DRAIN = false;
    bf16_t* P; const float* ssq; const float* cosT; const float* sinT; const float* vnorm;
    __device__ __forceinline__ void operator()(const f32x4 (&acc)[2][2][4][2], const Unit& u, int wr, int wc, int fr, int fq) const {
        const int pn = u.pn, row0 = u.pm * BM + wr * 64 + fr, cc = wc * 32 + 8 * fq;
        float rs[2][4];
#pragma unroll
        for (int ai = 0; ai < 2; ++ai)
#pragma unroll
            for (int m = 0; m < 4; ++m) rs[ai][m] = row_rstd(ssq, row0 + ai * HALF + m * 16);
#define MIX_ROWS(...) _Pragma("unroll") for (int ai = 0; ai < 2; ++ai) _Pragma("unroll") for (int m = 0; m < 4; ++m) { const int r = row0 + ai * HALF + m * 16; const float s = rs[ai][m]; \
            f32x4 a0 = acc[ai][0][m][0] * s, a1 = acc[ai][0][m][1] * s, b0 = acc[ai][1][m][0] * s, b1 = acc[ai][1][m][1] * s; bf16_t* prow = P + (size_t)r * PW; __VA_ARGS__ }
        if (pn == 2 || pn == 9 || pn == 10) {
            const int dst = (pn == 2 ? 512 : 2048 + 256 * (pn - 9)) + cc;
            MIX_ROWS( *(u32x4*)(prow + dst) = pack8(a0, a1); *(u32x4*)(prow + dst + 128) = pack8(b0, b1); )
        } else if (pn == 0) {
            MIX_ROWS( _Pragma("unroll") for (int e = 0; e < 4; ++e) { a0[e] = gelu_f(a0[e]); a1[e] = gelu_f(a1[e]); b0[e] = gelu_f(b0[e]); b1[e] = gelu_f(b1[e]); }
                      *(u32x4*)(prow + cc) = pack8(a0, a1); *(u32x4*)(prow + cc + 128) = pack8(b0, b1); )
        } else if (pn == 11 || pn == 12) {
            const int dst = 2560 + 256 * (pn - 11) + cc;
            MIX_ROWS( _Pragma("unroll") for (int e = 0; e < 4; ++e) { a0[e] = silu_f(a0[e]); a1[e] = silu_f(a1[e]); b0[e] = silu_f(b0[e]); b1[e] = silu_f(b1[e]); }
                      *(u32x4*)(prow + dst) = pack8(a0, a1); *(u32x4*)(prow + dst + 128) = pack8(b0, b1); )
        } else if (pn == 1) {
            const int ch0 = 64 * wc + 8 * fq;
            const f32x4 g0 = *(const f32x4*)(vnorm + ch0), g1 = *(const f32x4*)(vnorm + ch0 + 4), g2 = *(const f32x4*)(vnorm + ch0 + 32), g3 = *(const f32x4*)(vnorm + ch0 + 36);
            MIX_ROWS( float s1 = 0.f;
                      _Pragma("unroll") for (int e = 0; e < 4; ++e) { a0[e] = gelu_f(a0[e]); a1[e] = gelu_f(a1[e]); b0[e] = gelu_f(b0[e]); b1[e] = gelu_f(b1[e]); s1 += (a0[e] + a1[e]) + (b0[e] + b1[e]); }
                      s1 += __shfl_xor(s1, 16); s1 += __shfl_xor(s1, 32); const float mu = s1 * (1.0f / 64.0f); float s2 = 0.f;
                      a0 = a0 - mu; a1 = a1 - mu; b0 = b0 - mu; b1 = b1 - mu;
                      _Pragma("unroll") for (int e = 0; e < 4; ++e) s2 += (a0[e] * a0[e] + a1[e] * a1[e]) + (b0[e] * b0[e] + b1[e] * b1[e]);
                      s2 += __shfl_xor(s2, 16); s2 += __shfl_xor(s2, 32); const float rv = __builtin_amdgcn_rsqf(s2 * (1.0f / 64.0f) + 1e-6f);
                      a0 = a0 * rv * g0; a1 = a1 * rv * g1; b0 = b0 * rv * g2; b1 = b1 * rv * g3;
                      *(u32x4*)(prow + 256 + ch0) = pack8(a0, a1); *(u32x4*)(prow + 256 + ch0 + 32) = pack8(b0, b1); )
        } else if (pn == 3 || pn == 4) {
            const int dst = 768 + 128 * (pn - 3) + cc;
            MIX_ROWS( a0 = a0 * b0; a1 = a1 * b1; *(u32x4*)(prow + dst) = pack8(a0, a1); )
        } else {
            const bool isk = pn >= 7; const int hd = 2 * ((pn - 5) & 1) + (wc >> 1), i0 = 32 * (wc & 1) + 8 * fq;
            const float lg = hd == 0 ? -0.04580368961312479f : hd == 1 ? -0.02272007650008353f : hd == 2 ? -0.011315313227834146f : -0.005646563141142063f;
            const float lgs = isk ? -lg : lg; const int dst = (isk ? 1536 : 1024) + 128 * hd + i0;
            MIX_ROWS( const int pos = r & 2047; const float sc = fexp2((float)(r & 127) * lgs);
                      const f32x4 c0 = *(const f32x4*)(cosT + pos * 64 + i0), c1 = *(const f32x4*)(cosT + pos * 64 + i0 + 4), s0 = *(const f32x4*)(sinT + pos * 64 + i0), s1 = *(const f32x4*)(sinT + pos * 64 + i0 + 4);
                      const f32x4 o0 = (a0 * c0 - b0 * s0) * sc, o1 = (a1 * c1 - b1 * s1) * sc, p0 = (b0 * c0 + a0 * s0) * sc, p1 = (b1 * c1 + a1 * s1) * sc;
                      *(u32x4*)(prow + dst) = pack8(o0, o1); *(u32x4*)(prow + dst + 64) = pack8(p0, p1); )
        }
#undef MIX_ROWS
    }
};

template <class Epi, class Sched, bool ALIGN_EPI = false, bool SP2 = false>
__device__ __forceinline__ void gemm_phase(PG8_LAS unsigned char* lds, const Gemm g, const Sched& S, const Epi& E, const int tid  ) {
    const int wid = __builtin_amdgcn_readfirstlane(tid >> 6), lane = tid & 63, wr = wid >> 2, wc = wid & 3, fr = lane & 15, fq = lane >> 4;
    const int K = g.K, nt = K / BK;
    unsigned voffA[2], voffB[2];
#pragma unroll
    for (int i = 0; i < 2; ++i) { int R, C; stage_rc(tid * 16 + i * 8192, R, C); const int Rb = Epi::PERM ? ((R & ~31) + perm32(R & 31)) : R;
        voffA[i] = (unsigned)(R * K + C) * 2u; voffB[i] = (unsigned)(Rb * K + C) * 2u; }
    const size_t kstep = (size_t)(BK * 2);
    const size_t hstep = (size_t)HALF * K * 2;
    const size_t tstep = 2 * hstep;
    const unsigned ldsw = (unsigned)wid * 1024u;
    const int aoff = lds_byte(wr * 64 + fr, fq * 8), boff = lds_byte(wc * 32 + fr, fq * 8);
#define PG8_SA(b, h) (((b) * 2 + (h)) * HTB)
#define PG8_SB(b, h) ((4 + (b) * 2 + (h)) * HTB)
#define PG8_STAGE(bufoff, gbase, voff) do { _Pragma("unroll") for (int _i = 0; _i < 2; ++_i) \
        __builtin_amdgcn_global_load_lds((const unsigned*)((const char*)(gbase) + (voff)[_i]), (PG8_LAS unsigned*)(lds + (bufoff) + ldsw + _i * 8192), 16, 0, 0); } while (0)
#define PG8_LDA(dst, b, h) do { _Pragma("unroll") for (int m = 0; m < 4; ++m) _Pragma("unroll") for (int k = 0; k < 2; ++k) dst[m][k] = *(const PG8_LAS bf16x8*)(lds + PG8_SA(b, h) + aoff + m * 2048 + k * 1024); } while (0)
#define PG8_LDB(dst, b, h) do { _Pragma("unroll") for (int n = 0; n < 2; ++n) _Pragma("unroll") for (int k = 0; k < 2; ++k) dst[n][k] = *(const PG8_LAS bf16x8*)(lds + PG8_SB(b, h) + boff + n * 2048 + k * 1024); } while (0)
#define PG8_MMA(ai, bj, At, Bt) do { __builtin_amdgcn_s_setprio(1); _Pragma("unroll") for (int m = 0; m < 4; ++m) _Pragma("unroll") for (int n = 0; n < 2; ++n) _Pragma("unroll") for (int k = 0; k < 2; ++k) \
        acc[ai][bj][m][n] = __builtin_amdgcn_mfma_f32_16x16x32_bf16(Bt[n][k], At[m][k], acc[ai][bj][m][n], 0, 0, 0); __builtin_amdgcn_s_setprio(0); } while (0)
#define PG8_WAIT_V(n) asm volatile("s_waitcnt vmcnt(" #n ")" ::: "memory")
#define PG8_WAIT_L(n) asm volatile("s_waitcnt lgkmcnt(" #n ")" ::: "memory")
#define PG8_BAR __builtin_amdgcn_s_barrier()
#define PG8_SCHED __builtin_amdgcn_sched_barrier(0)
    Unit cur, nxt; int ui = 0;
    if (!S.next(0, cur)) return;
    f32x4 acc[2][2][4][2];
#pragma unroll
    for (int a = 0; a < 2; ++a)
#pragma unroll
        for (int b = 0; b < 2; ++b)
#pragma unroll
            for (int m = 0; m < 4; ++m)
#pragma unroll
                for (int n = 0; n < 2; ++n) acc[a][b][m][n] = (f32x4){0.f, 0.f, 0.f, 0.f};
    bf16x8 At[4][2], B0[2][2], B1[2][2];
    const char* cA = (const char*)g.A + (size_t)cur.pm * tstep; const char* cB = (const char*)g.Bt + (size_t)cur.pn * tstep;
    S.a_ready(cur);
    if constexpr (SP2) {
        PG8_STAGE(PG8_SB(0, 0), cB, voffB); PG8_STAGE(PG8_SB(0, 1), cB + hstep, voffB); PG8_STAGE(PG8_SA(0, 0), cA, voffA); PG8_STAGE(PG8_SA(0, 1), cA + hstep, voffA);
        if (wr == 1) PG8_BAR;
        PG8_WAIT_V(2); PG8_BAR;
        PG8_STAGE(PG8_SB(1, 0), cB + kstep, voffB); PG8_STAGE(PG8_SA(1, 0), cA + kstep, voffA); PG8_STAGE(PG8_SB(1, 1), cB + hstep + kstep, voffB);
        PG8_WAIT_V(6); PG8_BAR;
    } else {
        PG8_STAGE(PG8_SB(0, 0), cB, voffB); PG8_STAGE(PG8_SA(0, 0), cA, voffA); PG8_STAGE(PG8_SB(0, 1), cB + hstep, voffB); PG8_STAGE(PG8_SA(0, 1), cA + hstep, voffA);
        if (wr == 1) PG8_BAR;
        PG8_WAIT_V(4); PG8_BAR;
        PG8_STAGE(PG8_SB(1, 0), cB + kstep, voffB); PG8_STAGE(PG8_SA(1, 0), cA + kstep, voffA); PG8_STAGE(PG8_SB(1, 1), cB + hstep + kstep, voffB);
        PG8_WAIT_V(6); PG8_BAR;
    }
    for (;;) {
        const bool has_next = S.next(ui + 1, nxt);
        const char* nA = has_next ? (const char*)g.A + (size_t)nxt.pm * tstep : cA; const char* nB = has_next ? (const char*)g.Bt + (size_t)nxt.pn * tstep : cB;
        for (int t = 0; t < nt; t += 2) {
            const bool last = (t == nt - 2);
            const char* a1 = cA + (size_t)(t + 1) * kstep;
            const char* a2 = last ? nA : cA + (size_t)(t + 2) * kstep; const char* b2 = last ? nB : cB + (size_t)(t + 2) * kstep;
            const char* a3 = a2 + kstep; const char* b3 = b2 + kstep;
            if (last && has_next) S.a_ready(nxt);
            if constexpr (SP2) {
            PG8_LDB(B0, 0, 0); PG8_LDB(B1, 0, 1); PG8_SCHED; PG8_LDA(At, 0, 0); PG8_STAGE(PG8_SA(1, 1), a1 + hstep, voffA);
            PG8_WAIT_V(8); PG8_WAIT_L(0); PG8_BAR; PG8_MMA(0, 0, At, B0); PG8_MMA(0, 1, At, B1); PG8_BAR; PG8_SCHED;
            PG8_LDA(At, 0, 1); PG8_STAGE(PG8_SB(0, 0), b2, voffB); PG8_STAGE(PG8_SB(0, 1), b2 + hstep, voffB); PG8_STAGE(PG8_SA(0, 0), a2, voffA);
            PG8_WAIT_V(8); PG8_WAIT_L(0); PG8_BAR; PG8_MMA(1, 0, At, B0); PG8_MMA(1, 1, At, B1); PG8_BAR; PG8_SCHED;
            PG8_LDB(B0, 1, 0); PG8_LDB(B1, 1, 1); PG8_SCHED; PG8_LDA(At, 1, 0); PG8_STAGE(PG8_SA(0, 1), a2 + hstep, voffA);
            PG8_WAIT_V(8); PG8_WAIT_L(0); PG8_BAR; PG8_MMA(0, 0, At, B0); PG8_MMA(0, 1, At, B1); PG8_BAR; PG8_SCHED;
            PG8_LDA(At, 1, 1); PG8_STAGE(PG8_SB(1, 0), b3, voffB); PG8_STAGE(PG8_SB(1, 1), b3 + hstep, voffB); PG8_STAGE(PG8_SA(1, 0), a3, voffA);
            PG8_WAIT_V(8); PG8_WAIT_L(0); PG8_BAR; PG8_MMA(1, 0, At, B0); PG8_MMA(1, 1, At, B1); PG8_BAR; PG8_SCHED;
            } else {
            PG8_LDB(B0, 0, 0); PG8_SCHED; PG8_LDA(At, 0, 0); PG8_STAGE(PG8_SA(1, 1), a1 + hstep, voffA);
            PG8_WAIT_L(8); PG8_BAR; PG8_WAIT_L(0); PG8_MMA(0, 0, At, B0); PG8_BAR; PG8_SCHED;
            PG8_LDB(B1, 0, 1); PG8_STAGE(PG8_SB(0, 0), b2, voffB);
            PG8_BAR; PG8_WAIT_L(0); PG8_MMA(0, 1, At, B1); PG8_BAR;
            PG8_LDA(At, 0, 1); PG8_STAGE(PG8_SA(0, 0), a2, voffA);
            PG8_BAR; PG8_WAIT_L(0); PG8_MMA(1, 0, At, B0); PG8_BAR; PG8_SCHED;
            PG8_STAGE(PG8_SB(0, 1), b2 + hstep, voffB);
            PG8_WAIT_V(6); PG8_BAR; PG8_MMA(1, 1, At, B1); PG8_BAR;
            PG8_LDB(B0, 1, 0); PG8_SCHED; PG8_LDA(At, 1, 0); PG8_STAGE(PG8_SA(0, 1), a2 + hstep, voffA);
            PG8_WAIT_L(8); PG8_BAR; PG8_WAIT_L(0); PG8_MMA(0, 0, At, B0); PG8_BAR; PG8_SCHED;
            PG8_LDB(B1, 1, 1); PG8_STAGE(PG8_SB(1, 0), b3, voffB);
            PG8_BAR; PG8_WAIT_L(0); PG8_MMA(0, 1, At, B1); PG8_BAR;
            PG8_LDA(At, 1, 1); PG8_STAGE(PG8_SA(1, 0), a3, voffA);
            PG8_BAR; PG8_WAIT_L(0); PG8_MMA(1, 0, At, B0); PG8_BAR; PG8_SCHED;
            PG8_STAGE(PG8_SB(1, 1), b3 + hstep, voffB);
            PG8_WAIT_V(6); PG8_BAR; PG8_MMA(1, 1, At, B1); PG8_BAR;
            }
        }
        if constexpr (ALIGN_EPI) { if (wr == 0) PG8_BAR; }
        if constexpr (!Epi::AFTER_DRAIN) { E(acc, cur, wr, wc, fr, fq); S.done(cur); }
        if (!has_next) break;
#pragma unroll
        for (int a = 0; a < 2; ++a)
#pragma unroll
            for (int b = 0; b < 2; ++b)
#pragma unroll
                for (int m = 0; m < 4; ++m)
#pragma unroll
                    for (int n = 0; n < 2; ++n) acc[a][b][m][n] = (f32x4){0.f, 0.f, 0.f, 0.f};
        cur = nxt; cA = nA; cB = nB; ++ui;
        if constexpr (ALIGN_EPI) { if (wr == 1) PG8_BAR; }
    }
    PG8_WAIT_V(0);
    if constexpr (!ALIGN_EPI) { if (wr == 0) PG8_BAR; }
    PG8_BAR;
    if constexpr (Epi::AFTER_DRAIN) { E.fused(acc, cur, wr, wc, fr, fq, lds, wid, lane); S.done(cur); }
#undef PG8_SA
#undef PG8_SB
#undef PG8_STAGE
#undef PG8_LDA
#undef PG8_LDB
#undef PG8_MMA
#undef PG8_WAIT_V
#undef PG8_WAIT_L
#undef PG8_BAR
#undef PG8_SCHED
}
}
#define GAS __attribute__((address_space(1)))
#define LAS __attribute__((address_space(3)))
typedef unsigned short bf16;
typedef unsigned v4u __attribute__((ext_vector_type(4)));
typedef float f32x4 __attribute__((ext_vector_type(4)));
typedef short bf16x8 __attribute__((ext_vector_type(8)));
typedef GAS unsigned gu32;
typedef GAS unsigned long long gu64;
#define RLX_AGENT __ATOMIC_RELAXED, __HIP_MEMORY_SCOPE_AGENT
#define LDS_WAIT() asm volatile("s_waitcnt lgkmcnt(0)" ::: "memory")
#define VM_WAIT() asm volatile("s_waitcnt vmcnt(0)" ::: "memory")
__device__ __forceinline__ unsigned long long rt() { return __builtin_amdgcn_s_memrealtime(); }
__device__ __forceinline__ unsigned f2bf(float f) { unsigned u = __builtin_bit_cast(unsigned, f); return (u + 0x7fffu + ((u >> 16) & 1u)) >> 16; }
__device__ __forceinline__ unsigned pk2(float lo, float hi) { return f2bf(lo) | (f2bf(hi) << 16); }
#define XB_TMO      128
#define XB_XCNT(j)  (256  + 64 * (j))
#define XB_XSUB(j)  (1280 + 64 * (j))
#define XB_XGEN(j)  (2304 + 64 * (j))
#define XB_TOP      3328
#define XB_TOPGEN   3392
#define XCD_BAR_WORDS 3456
#define XB_SPIN_CAP (1u << 18)

__device__ __forceinline__ unsigned xb_ld(unsigned* p)              { return __hip_atomic_load(p, __ATOMIC_RELAXED, __HIP_MEMORY_SCOPE_AGENT); }
__device__ __forceinline__ unsigned xb_add(unsigned* p, unsigned v) { return __hip_atomic_fetch_add(p, v, __ATOMIC_RELAXED, __HIP_MEMORY_SCOPE_AGENT); }
__device__ __forceinline__ unsigned xb_xcc_id() { return (unsigned)__builtin_amdgcn_s_getreg((3 << 11) | 20) & 0xFu; }
#define XB_SPIN(cond, bar) do { unsigned _sp = 0; while (cond) { __builtin_amdgcn_s_sleep(1); \
    if ((++_sp & 255u) == 0u) { if (xb_ld(&(bar)[XB_TMO])) break; if (_sp > XB_SPIN_CAP) { atomicAdd(&(bar)[XB_TMO], 1u); break; } } } } while (0)

struct XcdBarrier {
    unsigned* bar; unsigned x;
    volatile LAS unsigned* st;
};

__device__ __forceinline__ XcdBarrier xcd_barrier_post(unsigned* bar, volatile LAS unsigned* st) {
    XcdBarrier b; b.bar = bar; b.x = xb_xcc_id(); b.st = st;
    if (threadIdx.x == 0) (void)xb_add(&bar[XB_XCNT(b.x)], 1u);
    return b;
}
__device__ __forceinline__ void xcd_barrier_complete(unsigned* bar, unsigned x, unsigned& nloc, unsigned& nx) {
    const unsigned G = gridDim.x * gridDim.y * gridDim.z;
    unsigned sum, cnt, mine, sp = 0u;
    for (;;) {
        sum = 0u; cnt = 0u; mine = 0u;
#pragma unroll
        for (unsigned j = 0; j < 16; ++j) { const unsigned c = xb_ld(&bar[XB_XCNT(j)]); sum += c; cnt += (c > 0u) ? 1u : 0u; mine = (j == x) ? c : mine; }
        if (sum == G) break;
        __builtin_amdgcn_s_sleep(1);
        if ((++sp & 255u) == 0u) { if (xb_ld(&bar[XB_TMO])) break; if (sp > XB_SPIN_CAP) { atomicAdd(&bar[XB_TMO], 1u); break; } }
    }
    nloc = mine > 0u ? mine : 1u; nx = cnt > 0u ? cnt : 1u;
}

__device__ __forceinline__ void xcd_barrier(const XcdBarrier& b) {
    asm volatile("s_waitcnt vmcnt(0)" ::: "memory");
    __syncthreads();
    if (threadIdx.x == 0) {
        unsigned* bar = b.bar;
        __builtin_amdgcn_s_waitcnt(0);
        unsigned nloc = b.st[0], nx = b.st[1];
        if (nloc == 0u) { xcd_barrier_complete(bar, b.x, nloc, nx); b.st[0] = nloc; b.st[1] = nx; }
        const unsigned old = xb_add(&bar[XB_XSUB(b.x)], 1u);
        const unsigned gen = old / nloc;
        if (old + 1u == (gen + 1u) * nloc) {
            __builtin_amdgcn_fence(__ATOMIC_RELEASE, "agent");
            asm volatile("s_waitcnt vmcnt(0)" ::: "memory");
            const unsigned og = xb_add(&bar[XB_TOP], 1u);
            const unsigned tg = og / nx;
            if (og + 1u == (tg + 1u) * nx) xb_add(&bar[XB_TOPGEN], 1u);
            else XB_SPIN(xb_ld(&bar[XB_TOPGEN]) == tg, bar);
            __builtin_amdgcn_fence(__ATOMIC_ACQUIRE, "agent");
            xb_add(&bar[XB_XGEN(b.x)], 1u);
            asm volatile("s_waitcnt vmcnt(0)" ::: "memory");
        } else {
            XB_SPIN(xb_ld(&bar[XB_XGEN(b.x)]) == gen, bar);
            __builtin_amdgcn_fence(__ATOMIC_ACQUIRE, "agent");
            asm volatile("s_waitcnt vmcnt(0)" ::: "memory");
        }
    }
    __syncthreads();
}
constexpr int NWAVES = 8;
#ifndef MK_N_LAUNCHES
#define MK_N_LAUNCHES 1
#endif
constexpr int N_PHASES = 20;
#ifndef PH_ENABLE
#define PH_ENABLE 0x1ff
#endif
#define EN(x) (((PH_ENABLE) >> (x)) & 1)
constexpr int N_LAUNCHES = MK_N_LAUNCHES;

constexpr int BATCH = 16, SEQ = 2048, D = 1024, M = BATCH * SEQ, FF = 2816, NGU = 2 * FF, NPROJ = 3328, PW = pg8::PW, CHUNK = 128, NCH = SEQ / CHUNK, NHEAD = 4;
constexpr float EPS = 1e-6f;

constexpr size_t MiB = 1u << 20;
constexpr size_t WS_CTL = 0, CTL_ZERO_BYTES = 1 * MiB;
constexpr size_t WS_SSQ = 1 * MiB;
constexpr size_t WS_COS = 2 * MiB, WS_SIN = 2 * MiB + 512 * 1024;
constexpr size_t WS_WTRIL = 3 * MiB;
constexpr size_t WS_W = 4 * MiB;
constexpr size_t W_GU = (size_t)NGU * D * 2, W_DN = (size_t)D * FF * 2, W_IN = (size_t)NPROJ * D * 2, W_OUT = (size_t)D * D * 2;
constexpr size_t WO_GU1 = 0, WO_D1 = WO_GU1 + W_GU, WO_IN = WO_D1 + W_DN, WO_OUT = WO_IN + W_IN, WO_GU2 = WO_OUT + W_OUT, WO_D2 = WO_GU2 + W_GU, W_LAYER = WO_D2 + W_DN;
static_assert(WS_W + 2 * W_LAYER <= 88 * MiB, "weights");
constexpr size_t WS_XB = 88 * MiB;
constexpr size_t WS_HP = 152 * MiB;
constexpr size_t WS_Y = 344 * MiB;
constexpr size_t WS_PT = 408 * MiB;
constexpr size_t WS_END = 440 * MiB;
constexpr int CW_BAR = 4096;

constexpr int RING_OFF = 0, RING_BYTES = 131072;
constexpr int TILE_LD = 272, TILE_BYTES = 128 * TILE_LD;
constexpr int SCR_BYTES = 4 * TILE_BYTES;
constexpr int LDSCTL_OFF = SCR_BYTES, MISC_OFF = LDSCTL_OFF + 320;
constexpr int LDS_BYTES = 147456;
static_assert(MISC_OFF + 128 <= LDS_BYTES && RING_BYTES <= SCR_BYTES, "LDS map");

typedef unsigned short u16x4 __attribute__((ext_vector_type(4)));
typedef unsigned u32x2 __attribute__((ext_vector_type(2)));
#define MFMA16(a, b, c) __builtin_amdgcn_mfma_f32_16x16x32_bf16((a), (b), (c), 0, 0, 0)
template <int LD> __device__ __forceinline__ bf16x8 tr_frag(unsigned addr) {
    u16x4 lo, hi;
    asm volatile("ds_read_b64_tr_b16 %0, %2\n\tds_read_b64_tr_b16 %1, %2 offset:%3\n\ts_waitcnt lgkmcnt(0)" : "=&v"(lo), "=&v"(hi) : "v"(addr), "i"(4 * LD) : "memory");
    bf16x8 r; r[0] = (short)lo[0]; r[1] = (short)lo[1]; r[2] = (short)lo[2]; r[3] = (short)lo[3]; r[4] = (short)hi[0]; r[5] = (short)hi[1]; r[6] = (short)hi[2]; r[7] = (short)hi[3]; return r;
}
__device__ __forceinline__ float bf2f(unsigned short h) { return __builtin_bit_cast(float, (unsigned)h << 16); }
__device__ __forceinline__ float bflo(unsigned w) { return __builtin_bit_cast(float, w << 16); }
__device__ __forceinline__ float bfhi(unsigned w) { return __builtin_bit_cast(float, w & 0xffff0000u); }
template <int NCOL, int LD> __device__ __forceinline__ void stage_tile(LAS unsigned char* dst, const bf16* src, int gpitch, int tid) {
    constexpr int CPR = NCOL / 8, NCHUNK = 128 * CPR;
#pragma unroll
    for (int i = 0; i < NCHUNK / 512; ++i) { const int c = tid + 512 * i, row = c / CPR, ch = c % CPR;
        const v4u v = *(const GAS v4u*)(src + (size_t)row * gpitch + ch * 8); *(LAS v4u*)(dst + row * LD + ch * 16) = v; }
}
__device__ __forceinline__ float wave_sum(float v) {
#pragma unroll
    for (int o = 1; o < 64; o <<= 1) v += __shfl_xor(v, o);
    return v;
}

__device__ __forceinline__ void tr_item(const float* W, int N, int K, bf16* WT, int dst_row0, int src_col0, int k0, const float* gain, float cscale, LAS float* scr, int lane) {
#pragma unroll 8
    for (int i = 0; i < 32; ++i) { const int kk = 2 * i + (lane >> 5); const float g = gain ? gain[k0 + kk] * cscale : cscale; scr[kk * 33 + (lane & 31)] = W[(size_t)(k0 + kk) * N + src_col0 + (lane & 31)] * g; }
    LDS_WAIT(); asm volatile("" ::: "memory");
    const int c = lane & 7;
#pragma unroll
    for (int j = 0; j < 4; ++j) { const int n = (lane >> 3) + 8 * j; const LAS float* s = scr + (8 * c) * 33 + n;
        v4u o; o.x = pk2(s[0 * 33], s[1 * 33]); o.y = pk2(s[2 * 33], s[3 * 33]); o.z = pk2(s[4 * 33], s[5 * 33]); o.w = pk2(s[6 * 33], s[7 * 33]);
        *(GAS v4u*)(WT + (size_t)(dst_row0 + n) * K + k0 + 8 * c) = o; }
    LDS_WAIT(); asm volatile("" ::: "memory");
}
__device__ __forceinline__ int win_src_col(int pn, int c) {
    switch (pn) {
        case 0: return c;
        case 1: return 256 + 64 * ((c >> 5) & 3) + 32 * (c >> 7);
        case 2: return 512 + c;
        case 3: case 4: return (c < 128 ? 768 : 1024 - 128) + 128 * (pn - 3) + c;
        case 5: case 6: { const int cp = c & 127; return 1280 + 128 * (2 * (pn - 5) + (cp >> 6)) + (c < 128 ? 0 : 64) + (cp & 63); }
        case 7: case 8: { const int cp = c & 127; return 1792 + 128 * (2 * (pn - 7) + (cp >> 6)) + (c < 128 ? 0 : 64) + (cp & 63); }
        case 9: case 10: return 2304 + 256 * (pn - 9) + c;
        default: return 2816 + 256 * (pn - 11) + c;
    }
}

struct Args { const float* in[18]; float* out; unsigned char* ws; int ph_lo, ph_hi, li, pad; };

__global__ void __launch_bounds__(NWAVES * 64, 2) fwd_kernel(Args args) {
    extern __shared__ __attribute__((aligned(16))) unsigned char lds_raw[];
    LAS unsigned char* lds = (LAS unsigned char*)lds_raw;
    volatile LAS unsigned* MISC = (volatile LAS unsigned*)(lds + MISC_OFF);
    const int tid = threadIdx.x, wave = __builtin_amdgcn_readfirstlane(tid >> 6);
    const int G = gridDim.x, bid = blockIdx.x;
    const unsigned lds_base = (unsigned)(uintptr_t)lds;
    unsigned char* ws = args.ws;
    gu32* ctl = (gu32*)(ws + WS_CTL);
    float* ssqb = (float*)(ws + WS_SSQ);
    float* cosT = (float*)(ws + WS_COS); float* sinT = (float*)(ws + WS_SIN);
    bf16* WTRIL = (bf16*)(ws + WS_WTRIL);
    bf16* XB = (bf16*)(ws + WS_XB); float* KVT = (float*)(ws + WS_XB);
    bf16* HP = (bf16*)(ws + WS_HP); bf16* Y = (bf16*)(ws + WS_Y); bf16* PT = (bf16*)(ws + WS_PT);
    float* X = args.out;

    for (int u = tid; u < (LDS_BYTES - LDSCTL_OFF) / 4; u += NWAVES * 64) ((LAS unsigned*)(lds + LDSCTL_OFF))[u] = 0u;
    __syncthreads();
    XcdBarrier bar; bar.bar = (unsigned*)(ctl + CW_BAR); bar.x = 0; bar.st = nullptr;
    if (N_LAUNCHES == 1) bar = xcd_barrier_post((unsigned*)(ctl + CW_BAR), MISC + 8);
    const int lo = args.ph_lo, hi = args.ph_hi;
#define IN(k) (lo <= (k) && (k) < hi)
#define LAUNDER() int ptid = tid; asm volatile("" : "+v"(ptid)); const int lane = ptid & 63, l15 = lane & 15, q4 = lane >> 4, tq = l15 >> 2, tp = lane & 3; (void)l15; (void)q4; (void)tq; (void)tp; (void)lane
#define SEAM(k) do { if (IN(k) && IN((k) + 1)) xcd_barrier(bar); } while (0)

    if (EN(0) && IN(0)) {
            LAUNDER();
        LAS float* scr = (LAS float*)(lds + wave * 16384);
        const int gw = bid * NWAVES + wave, NGW = G * NWAVES;
        constexpr int I_GU = (NGU / 32) * (D / 64), I_DN = (D / 32) * (FF / 64), I_IN = (NPROJ / 32) * (D / 64), I_OUT = (D / 32) * (D / 64), I_LAYER = 2 * I_GU + 2 * I_DN + I_IN + I_OUT;
        for (int it = gw; it < 2 * I_LAYER; it += NGW) {
            const int l = it / I_LAYER; int r = it % I_LAYER; bf16* WL = (bf16*)(ws + WS_W + (size_t)l * W_LAYER);
            if (r < 2 * I_GU) {
                const int f = r / I_GU; r %= I_GU; const int rb = r / (D / 64), kb = r % (D / 64), pn = rb >> 3, cb = rb & 7;
                const float* Wsrc = args.in[(f ? 14 : 2) + (cb >= 4 ? 1 : 0)] + (size_t)l * D * FF;
                tr_item(Wsrc, FF, D, (bf16*)((unsigned char*)WL + (f ? WO_GU2 : WO_GU1)), rb * 32, 128 * pn + 32 * (cb & 3), kb * 64, args.in[f ? 13 : 1] + l * D, 1.f, scr, lane);
                continue; }
            r -= 2 * I_GU;
            if (r < 2 * I_DN) {
                const int f = r / I_DN; r %= I_DN; const int rb = r / (FF / 64), kb = r % (FF / 64);
                tr_item(args.in[f ? 16 : 4] + (size_t)l * FF * D, D, FF, (bf16*)((unsigned char*)WL + (f ? WO_D2 : WO_D1)), rb * 32, rb * 32, kb * 64, nullptr, 0.5f, scr, lane);
                continue; }
            r -= 2 * I_DN;
            if (r < I_IN) {
                const int rb = r / (D / 64), kb = r % (D / 64), pn = rb >> 3, c = (rb & 7) * 32;
                tr_item(args.in[6] + (size_t)l * D * NPROJ, NPROJ, D, (bf16*)((unsigned char*)WL + WO_IN), rb * 32, win_src_col(pn, c), kb * 64, args.in[5] + l * D, (pn == 7 || pn == 8) ? 0.08838834764831845f : 1.f, scr, lane);
                continue; }
            r -= I_IN;
            { const int rb = r / (D / 64), kb = r % (D / 64);
              tr_item(args.in[12] + (size_t)l * D * D, D, D, (bf16*)((unsigned char*)WL + WO_OUT), rb * 32, rb * 32, kb * 64, nullptr, 1.f, scr, lane); }
        }
        const float* xin = args.in[0];
        for (int m = gw; m < M; m += NGW) {
            const GAS f32x4* xr = (const GAS f32x4*)(xin + (size_t)m * D) + lane; f32x4 v[4]; float s = 0.f;
#pragma unroll
            for (int j = 0; j < 4; ++j) { v[j] = xr[64 * j]; s += (v[j].x * v[j].x + v[j].y * v[j].y) + (v[j].z * v[j].z + v[j].w * v[j].w); }
            s = wave_sum(s);
            GAS unsigned long long* o8 = (GAS unsigned long long*)(XB + (size_t)m * D) + lane;
#pragma unroll
            for (int j = 0; j < 4; ++j) o8[64 * j] = (unsigned long long)pk2(v[j].x, v[j].y) | ((unsigned long long)pk2(v[j].z, v[j].w) << 32);
            if (lane == 0) { __hip_atomic_store(ssqb + m, s, RLX_AGENT); __hip_atomic_store(ssqb + M + m, 0.f, RLX_AGENT); }
        }
        const int gt = bid * (NWAVES * 64) + ptid, NGT = G * NWAVES * 64;
        for (int i = gt; i < SEQ * 64; i += NGT) {
            const int pos = i >> 6, fi = i & 63; double inv = 1.0; for (int k = 0; k < fi; ++k) inv *= 0.8659643233600653;
            double turns = (double)pos * inv * 0.15915494309189535; turns -= __builtin_floor(turns);
            cosT[i] = __builtin_amdgcn_cosf((float)turns); sinT[i] = __builtin_amdgcn_sinf((float)turns);
        }
        for (int i = gt; i < 2 * 4 * 128 * 128; i += NGT) { const int t = (i >> 7) & 127, s = i & 127; WTRIL[i] = (bf16)(s <= t ? f2bf(args.in[8][i]) : 0u); }
    }
    SEAM(0);

    int ph = 1, cur = 0;
#pragma unroll 1
    for (int step = 0; step < 4; ++step) {
        const int l = step >> 1, f = step & 1;
        unsigned char* WL = ws + WS_W + (size_t)l * W_LAYER;
        if (EN(1) && IN(ph)) {
            LAUNDER();
            for (int i = bid * 512 + ptid; i < M; i += G * 512) __hip_atomic_store(ssqb + (cur ^ 1) * M + i, 0.f, RLX_AGENT);
            pg8::Gemm g{XB, (const bf16*)(WL + (f ? WO_GU2 : WO_GU1)), M, NGU, D}; pg8::StaticOrder S; S.init(M, NGU, G, bid);
            pg8::EpiSwiglu E{HP, ssqb + cur * M};
            pg8::gemm_phase<pg8::EpiSwiglu, pg8::StaticOrder, true, true>(lds + RING_OFF, g, S, E, ptid);
        }
        SEAM(ph); ++ph;
        if (EN(2) && IN(ph)) {
            LAUNDER();
            pg8::Gemm g{HP, (const bf16*)(WL + (f ? WO_D2 : WO_D1)), M, D, FF}; pg8::StaticOrder S; S.init(M, D, G, bid);
            pg8::EpiResid E{(step == 0) ? args.in[0] : X, X, XB, ssqb + (cur ^ 1) * M};
            pg8::gemm_phase<pg8::EpiResid, pg8::StaticOrder, true, true>(lds + RING_OFF, g, S, E, ptid);
        }
        SEAM(ph); ++ph; cur ^= 1;
        if (f == 0) {
            if (EN(3) && IN(ph)) {
            LAUNDER();
                for (int i = bid * 512 + ptid; i < M; i += G * 512) __hip_atomic_store(ssqb + (cur ^ 1) * M + i, 0.f, RLX_AGENT);
                pg8::Gemm g{XB, (const bf16*)(WL + WO_IN), M, NPROJ, D}; pg8::StaticOrder S; S.init(M, NPROJ, G, bid);
                pg8::EpiMix E{HP, ssqb + cur * M, cosT, sinT, args.in[7] + l * 256};
                pg8::gemm_phase<pg8::EpiMix, pg8::StaticOrder, true, true>(lds + RING_OFF, g, S, E, ptid);
            }
            SEAM(ph); ++ph;
            if (EN(4) && IN(ph)) {
            LAUNDER();
                for (int un = bid; un < BATCH * NCH * 4; un += G) {
                    const int gq = un & 3, bn = un >> 2, R0 = bn * CHUNK;
                    stage_tile<128, TILE_LD>(lds, WTRIL + (size_t)(l * 4 + gq) * 16384, 128, ptid);
                    stage_tile<64, 144>(lds + TILE_BYTES, HP + (size_t)R0 * PW + 256 + 64 * gq, PW, ptid);
                    __syncthreads();
                    f32x4 acc[4];
#pragma unroll
                    for (int db = 0; db < 4; ++db) acc[db] = (f32x4){0.f, 0.f, 0.f, 0.f};
                    const int kmax = wave >> 1;
#pragma unroll
                    for (int ks = 0; ks < 4; ++ks) if (ks <= kmax) {
                        const bf16x8 bw = *(const LAS bf16x8*)(lds + (16 * wave + l15) * TILE_LD + (32 * ks + 8 * q4) * 2);
#pragma unroll
                        for (int db = 0; db < 4; ++db) { const bf16x8 av = tr_frag<144>(lds_base + TILE_BYTES + (32 * ks + 8 * q4 + tq) * 144 + (16 * db + 4 * tp) * 2); acc[db] = MFMA16(av, bw, acc[db]); }
                    }
                    const int t = 16 * wave + l15, row = R0 + t; const float bsv = args.in[9][(l * 4 + gq) * 128 + t];
#pragma unroll
                    for (int db = 0; db < 4; ++db) { const int col = 64 * gq + 16 * db + 4 * q4;
                        const u32x2 uu = *(const GAS u32x2*)(HP + (size_t)row * PW + col);
                        u32x2 o; o.x = pg8::cvt_pk_bf16(bflo(uu.x) * (acc[db][0] + bsv), bfhi(uu.x) * (acc[db][1] + bsv)); o.y = pg8::cvt_pk_bf16(bflo(uu.y) * (acc[db][2] + bsv), bfhi(uu.y) * (acc[db][3] + bsv));
                        *(GAS u32x2*)(Y + (size_t)row * D + col) = o; }
                    __syncthreads();
                }
                for (int it = bid * 512 + ptid; it < (M / 8) * 32; it += G * 512) {
                    const int rb = it >> 5, c8 = (it & 31) * 8, row0 = rb * 8; const float* cw = args.in[10] + l * 768 + c8;
                    float w0[8], w1[8], w2[8], z2[8], z1[8];
#pragma unroll
                    for (int j = 0; j < 8; ++j) { w0[j] = cw[j]; w1[j] = cw[256 + j]; w2[j] = cw[512 + j]; z2[j] = 0.f; z1[j] = 0.f; }
                    if ((row0 & (SEQ - 1)) != 0) {
                        const v4u a = *(const GAS v4u*)(HP + (size_t)(row0 - 2) * PW + 768 + c8), b = *(const GAS v4u*)(HP + (size_t)(row0 - 1) * PW + 768 + c8);
                        z2[0] = bflo(a.x); z2[1] = bfhi(a.x); z2[2] = bflo(a.y); z2[3] = bfhi(a.y); z2[4] = bflo(a.z); z2[5] = bfhi(a.z); z2[6] = bflo(a.w); z2[7] = bfhi(a.w);
                        z1[0] = bflo(b.x); z1[1] = bfhi(b.x); z1[2] = bflo(b.y); z1[3] = bfhi(b.y); z1[4] = bflo(b.z); z1[5] = bfhi(b.z); z1[6] = bflo(b.w); z1[7] = bfhi(b.w);
                    }
#pragma unroll
                    for (int j = 0; j < 8; ++j) {
                        const v4u zc = *(const GAS v4u*)(HP + (size_t)(row0 + j) * PW + 768 + c8), bg = *(const GAS v4u*)(HP + (size_t)(row0 + j) * PW + 512 + c8);
                        float z0[8], g8[8], y[8];
                        z0[0] = bflo(zc.x); z0[1] = bfhi(zc.x); z0[2] = bflo(zc.y); z0[3] = bfhi(zc.y); z0[4] = bflo(zc.z); z0[5] = bfhi(zc.z); z0[6] = bflo(zc.w); z0[7] = bfhi(zc.w);
                        g8[0] = bflo(bg.x); g8[1] = bfhi(bg.x); g8[2] = bflo(bg.y); g8[3] = bfhi(bg.y); g8[4] = bflo(bg.z); g8[5] = bfhi(bg.z); g8[6] = bflo(bg.w); g8[7] = bfhi(bg.w);
#pragma unroll
                        for (int k = 0; k < 8; ++k) { y[k] = g8[k] * (w0[k] * z2[k] + w1[k] * z1[k] + w2[k] * z0[k]); z2[k] = z1[k]; z1[k] = z0[k]; }
                        v4u o; o.x = pg8::cvt_pk_bf16(y[0], y[1]); o.y = pg8::cvt_pk_bf16(y[2], y[3]); o.z = pg8::cvt_pk_bf16(y[4], y[5]); o.w = pg8::cvt_pk_bf16(y[6], y[7]);
                        *(GAS v4u*)(Y + (size_t)(row0 + j) * D + 256 + c8) = o;
                    }
                }
                for (int un = bid; un < BATCH * NCH * NHEAD; un += G) {
                    const int h = un & 3, bn = un >> 2, R0 = bn * CHUNK;
                    stage_tile<128, TILE_LD>(lds, HP + (size_t)R0 * PW + 1536 + 128 * h, PW, ptid);
                    stage_tile<128, TILE_LD>(lds + TILE_BYTES, HP + (size_t)R0 * PW + 2048 + 128 * h, PW, ptid);
                    __syncthreads();
                    f32x4 acc[8];
#pragma unroll
                    for (int db = 0; db < 8; ++db) acc[db] = (f32x4){0.f, 0.f, 0.f, 0.f};
#pragma unroll
                    for (int ks = 0; ks < 4; ++ks) {
                        const bf16x8 bv = tr_frag<TILE_LD>(lds_base + TILE_BYTES + (32 * ks + 8 * q4 + tq) * TILE_LD + (16 * wave + 4 * tp) * 2);
#pragma unroll
                        for (int db = 0; db < 8; ++db) { const bf16x8 ak = tr_frag<TILE_LD>(lds_base + (32 * ks + 8 * q4 + tq) * TILE_LD + (16 * db + 4 * tp) * 2); acc[db] = MFMA16(ak, bv, acc[db]); }
                    }
                    float* kv = KVT + (size_t)un * 16384 + (16 * wave + l15) * 128 + 4 * q4;
#pragma unroll
                    for (int db = 0; db < 8; ++db) *(GAS f32x4*)(kv + 16 * db) = acc[db];
                    __syncthreads();
                }
            }
            SEAM(ph); ++ph;
            if (EN(5) && IN(ph)) {
            LAUNDER();
                for (int it = bid * 512 + ptid; it < BATCH * NHEAD * 4096; it += G * 512) {
                    const int e4 = it & 4095, h = (it >> 12) & 3, b = it >> 14;
                    const float lg = h == 0 ? -0.04580368961312479f : h == 1 ? -0.02272007650008353f : h == 2 ? -0.011315313227834146f : -0.005646563141142063f;
                    const float Gam = pg8::fexp2(128.f * lg);
                    f32x4 kv[NCH];
#pragma unroll
                    for (int n = 0; n < NCH; ++n) kv[n] = *(const GAS f32x4*)(KVT + (size_t)((b * NCH + n) * 4 + h) * 16384 + e4 * 4);
                    f32x4 st = (f32x4){0.f, 0.f, 0.f, 0.f};
#pragma unroll
                    for (int n = 0; n < NCH; ++n) {
                        u32x2 o; o.x = pg8::cvt_pk_bf16(st[0], st[1]); o.y = pg8::cvt_pk_bf16(st[2], st[3]);
                        *(GAS u32x2*)(PT + (size_t)((b * NCH + n) * 4 + h) * 16384 + e4 * 4) = o;
                        st = (st + kv[n]) * Gam;
                    }
                }
            }
            SEAM(ph); ++ph;
            if (EN(6) && IN(ph)) {
            LAUNDER();
                constexpr int RQ = 0, RK = TILE_BYTES, RV = 2 * TILE_BYTES, RP = 3 * TILE_BYTES;
                for (int un = bid; un < BATCH * NCH * NHEAD; un += G) {
                    const int h = un & 3, bn = un >> 2, R0 = bn * CHUNK;
                    stage_tile<128, TILE_LD>(lds + RQ, HP + (size_t)R0 * PW + 1024 + 128 * h, PW, ptid);
                    stage_tile<128, TILE_LD>(lds + RK, HP + (size_t)R0 * PW + 1536 + 128 * h, PW, ptid);
                    stage_tile<128, TILE_LD>(lds + RV, HP + (size_t)R0 * PW + 2048 + 128 * h, PW, ptid);
                    stage_tile<128, TILE_LD>(lds + RP, PT + (size_t)un * 16384, 128, ptid);
                    __syncthreads();
                    const int t = 16 * wave + l15, wlim = wave | 1, kmax = wave >> 1;
                    bf16x8 bq[4];
#pragma unroll
                    for (int ks = 0; ks < 4; ++ks) bq[ks] = *(const LAS bf16x8*)(lds + RQ + t * TILE_LD + (32 * ks + 8 * q4) * 2);
                    f32x4 Sa[8];
#pragma unroll
                    for (int cb = 0; cb < 8; ++cb) { Sa[cb] = (f32x4){0.f, 0.f, 0.f, 0.f};
                        if (cb <= wlim) {
#pragma unroll
                            for (int ks = 0; ks < 4; ++ks) { const bf16x8 ak = *(const LAS bf16x8*)(lds + RK + (16 * cb + l15) * TILE_LD + (32 * ks + 8 * q4) * 2); Sa[cb] = MFMA16(ak, bq[ks], Sa[cb]); }
#pragma unroll
                            for (int e = 0; e < 4; ++e) if (16 * cb + 4 * q4 + e > t) Sa[cb][e] = 0.f;
                        } }
                    __syncthreads();
#pragma unroll
                    for (int cb = 0; cb < 8; ++cb) if (cb <= wlim) { u32x2 o; o.x = pg8::cvt_pk_bf16(Sa[cb][0], Sa[cb][1]); o.y = pg8::cvt_pk_bf16(Sa[cb][2], Sa[cb][3]);
                        *(LAS u32x2*)(lds + RK + t * TILE_LD + (16 * cb + 4 * q4) * 2) = o; }
                    LDS_WAIT(); asm volatile("" ::: "memory");
                    f32x4 Ra[8];
#pragma unroll
                    for (int vb = 0; vb < 8; ++vb) Ra[vb] = (f32x4){0.f, 0.f, 0.f, 0.f};
#pragma unroll
                    for (int ks = 0; ks < 4; ++ks) if (ks <= kmax) {
                        const bf16x8 bs = *(const LAS bf16x8*)(lds + RK + t * TILE_LD + (32 * ks + 8 * q4) * 2);
#pragma unroll
                        for (int vb = 0; vb < 8; ++vb) { const bf16x8 av = tr_frag<TILE_LD>(lds_base + RV + (32 * ks + 8 * q4 + tq) * TILE_LD + (16 * vb + 4 * tp) * 2); Ra[vb] = MFMA16(av, bs, Ra[vb]); }
                    }
#pragma unroll
                    for (int ks = 0; ks < 4; ++ks) {
#pragma unroll
                        for (int vb = 0; vb < 8; ++vb) { const bf16x8 ap = *(const LAS bf16x8*)(lds + RP + (16 * vb + l15) * TILE_LD + (32 * ks + 8 * q4) * 2); Ra[vb] = MFMA16(ap, bq[ks], Ra[vb]); }
                    }
                    float s1 = 0.f;
#pragma unroll
                    for (int vb = 0; vb < 8; ++vb) s1 += (Ra[vb][0] + Ra[vb][1]) + (Ra[vb][2] + Ra[vb][3]);
                    s1 += __shfl_xor(s1, 16); s1 += __shfl_xor(s1, 32);
                    const float mu = s1 * (1.0f / 128.0f); float s2 = 0.f;
#pragma unroll
                    for (int vb = 0; vb < 8; ++vb) { Ra[vb] = Ra[vb] - mu; s2 += (Ra[vb][0] * Ra[vb][0] + Ra[vb][1] * Ra[vb][1]) + (Ra[vb][2] * Ra[vb][2] + Ra[vb][3] * Ra[vb][3]); }
                    s2 += __shfl_xor(s2, 16); s2 += __shfl_xor(s2, 32);
                    const float rstd = __builtin_amdgcn_rsqf(s2 * (1.0f / 128.0f) + EPS);
                    const int row = R0 + t; const float* gnp = args.in[11] + l * 512 + 128 * h;
#pragma unroll
                    for (int vb = 0; vb < 8; ++vb) { const int v0 = 16 * vb + 4 * q4;
                        const f32x4 gv = *(const GAS f32x4*)(gnp + v0); const u32x2 gg = *(const GAS u32x2*)(HP + (size_t)row * PW + 2560 + 128 * h + v0);
                        u32x2 o; o.x = pg8::cvt_pk_bf16(Ra[vb][0] * rstd * gv[0] * bflo(gg.x), Ra[vb][1] * rstd * gv[1] * bfhi(gg.x)); o.y = pg8::cvt_pk_bf16(Ra[vb][2] * rstd * gv[2] * bflo(gg.y), Ra[vb][3] * rstd * gv[3] * bfhi(gg.y));
                        *(GAS u32x2*)(Y + (size_t)row * D + 512 + 128 * h + v0) = o; }
                    __syncthreads();
                }
            }
            SEAM(ph); ++ph;
            if (EN(7) && IN(ph)) {
            LAUNDER();
                pg8::Gemm g{Y, (const bf16*)(WL + WO_OUT), M, D, D}; pg8::StaticOrder S; S.init(M, D, G, bid);
                pg8::EpiResid E{X, X, XB, ssqb + (cur ^ 1) * M};
                pg8::gemm_phase<pg8::EpiResid, pg8::StaticOrder, true, true>(lds + RING_OFF, g, S, E, ptid);
            }
            SEAM(ph); ++ph; cur ^= 1;
        }
    }
    if (EN(8) && IN(ph)) {
            LAUNDER();
        const int gw = bid * NWAVES + wave, NGW = G * NWAVES; const float* fg = args.in[17];
        f32x4 gv[4];
#pragma unroll
        for (int j = 0; j < 4; ++j) gv[j] = *((const GAS f32x4*)fg + lane + 64 * j);
        for (int m = gw; m < M; m += NGW) {
            GAS f32x4* xr = (GAS f32x4*)(X + (size_t)m * D) + lane; f32x4 v[4]; float s = 0.f;
#pragma unroll
            for (int j = 0; j < 4; ++j) { v[j] = xr[64 * j]; s += (v[j].x * v[j].x + v[j].y * v[j].y) + (v[j].z * v[j].z + v[j].w * v[j].w); }
            const float rstd = __builtin_amdgcn_rsqf(wave_sum(s) * (1.0f / D) + EPS);
#pragma unroll
            for (int j = 0; j < 4; ++j) xr[64 * j] = v[j] * rstd * gv[j];
        }
    }
#undef IN
#undef SEAM
}

extern "C" void kernel_launch(void* const* d_in, const int* in_sizes, int n_in, void* d_out, int out_size, void* d_ws, size_t ws_size, hipStream_t stream) {
    static int grid = 0;
    if (grid == 0) {
        if (n_in != 18 || in_sizes[0] != M * D || out_size != M * D || ws_size < WS_END) { fprintf(stderr, "kernel_launch: shape/workspace mismatch (n_in %d, in0 %d, out %d, ws %zu); nothing launched\n", n_in, n_in > 0 ? in_sizes[0] : -1, out_size, ws_size); grid = -1; return; }
        int dev = 0, cus = 0, per_cu = 0;
        if (hipGetDevice(&dev) != hipSuccess || hipDeviceGetAttribute(&cus, hipDeviceAttributeMultiprocessorCount, dev) != hipSuccess) { grid = -1; return; }
        if (hipFuncSetAttribute((const void*)fwd_kernel, hipFuncAttributeMaxDynamicSharedMemorySize, LDS_BYTES) != hipSuccess) { fprintf(stderr, "kernel_launch: hipFuncSetAttribute failed\n"); grid = -1; return; }
        if (hipOccupancyMaxActiveBlocksPerMultiprocessor(&per_cu, (const void*)fwd_kernel, NWAVES * 64, LDS_BYTES) != hipSuccess || per_cu < 1)
            fprintf(stderr, "kernel_launch: note: occupancy query reports %d workgroups per CU\n", per_cu);
        (void)hipGetLastError();
        grid = cus;
    }
    if (grid < 0) return;
    if (hipMemsetAsync((char*)d_ws + WS_CTL, 0, CTL_ZERO_BYTES, stream) != hipSuccess) return;
    Args a{};
    for (int i = 0; i < 18; ++i) a.in[i] = (const float*)d_in[i];
    a.out = (float*)d_out; a.ws = (unsigned char*)d_ws;
    for (int li = 0; li < N_LAUNCHES; ++li) {
        a.ph_lo = (N_LAUNCHES == 1) ? 0 : li; a.ph_hi = (N_LAUNCHES == 1) ? N_PHASES : li + 1; a.li = li; a.pad = 0;
        hipLaunchKernelGGL(fwd_kernel, dim3(grid), dim3(NWAVES * 64), LDS_BYTES, stream, a);
        const hipError_t le = hipPeekAtLastError();
        if (le != hipSuccess) { fprintf(stderr, "kernel_launch: launch %d failed: %s\n", li, hipGetErrorName(le)); break; }
    }
}
```

```cpp
#include <hip/hip_runtime.h>
#include <cstdio>
#include <cstdint>
namespace pg8 {
#define PG8_LAS __attribute__((address_space(3)))
typedef unsigned short bf16_t;
typedef short bf16x8 __attribute__((ext_vector_type(8)));
typedef float f32x4 __attribute__((ext_vector_type(4)));
typedef unsigned u32x4 __attribute__((ext_vector_type(4)));
typedef int i32x4 __attribute__((ext_vector_type(4)));
typedef int i32x8 __attribute__((ext_vector_type(8)));
constexpr int BM = 256, BK = 64, HALF = 128, HTB = HALF * BK * 2  , STAGE_BYTES = 8 * HTB, NXCD = 8, WGM = 8;

__host__ __device__ __forceinline__ int lds_byte(int r, int c) { const int st = (r >> 4) * 2 + (c >> 5), rr = r & 15, cc = c & 31, ob = rr * 64 + cc * 2; return st * 1024 + (ob ^ (((ob >> 9) & 1) << 5)); }
__host__ __device__ __forceinline__ void stage_rc(int b, int& R, int& C) { const int st = b / 1024, sb = b % 1024, swz = sb ^ (((sb >> 9) & 1) << 5); R = (st >> 1) * 16 + swz / 64; C = (st & 1) * 32 + (swz % 64) / 2; }
__host__ __device__ __forceinline__ int perm32(int rho) { const int n = rho >> 4, i = rho & 15; return 8 * (i >> 2) + 4 * n + (i & 3); }

struct Unit { int pm, pn; };
struct Gemm { const bf16_t* A; const bf16_t* Bt; int M, N, K; unsigned a_pad = 0; };

struct StaticOrder {
    int nM, nN, nwg, G, c;
    __host__ __device__ void init(int M, int N, int G_, int c_) { nM = M / BM; nN = N / BM; nwg = nM * nN; G = G_; c = c_; }
    __host__ __device__ bool next(int i, Unit& u) const {
        const long L = (long)i * G + c; if (L >= nwg) return false;
        int wgid = (int)L; { const int q = nwg / NXCD, r = nwg % NXCD, xcd = wgid % NXCD, off = wgid / NXCD; wgid = (xcd < r ? xcd * (q + 1) : r * (q + 1) + (xcd - r) * q) + off; }
        const int nig = WGM * nN, gid = wgid / nig, fm = gid * WGM, gsz = (nM % WGM == 0) ? WGM : ((nM - fm) < WGM ? (nM - fm) : WGM);
        u.pm = fm + ((wgid % nig) % gsz); u.pn = (wgid % nig) / gsz; return true;
    }
    __device__ __forceinline__ void a_ready(const Unit&) const {}
    __device__ __forceinline__ void done(const Unit&) const {}
};

typedef float f32x2_cv __attribute__((ext_vector_type(2))); typedef __bf16 bf16x2_cv __attribute__((ext_vector_type(2)));
__device__ __forceinline__ unsigned cvt_pk_bf16(float lo, float hi) { const f32x2_cv v = {lo, hi}; const bf16x2_cv b = __builtin_convertvector(v, bf16x2_cv); return __builtin_bit_cast(unsigned, b); }
typedef float f32x2 __attribute__((ext_vector_type(2)));
typedef float f32x2 __attribute__((ext_vector_type(2)));
__device__ __forceinline__ float fexp2(float x) { return __builtin_amdgcn_exp2f(x); }
__device__ __forceinline__ float frcp(float x) { return __builtin_amdgcn_rcpf(x); }
__device__ __forceinline__ float silu_f(float x) { return x * frcp(1.f + fexp2(-1.4426950408889634f * x)); }
__device__ __forceinline__ float gelu_f(float x) { const float u = x * (1.f + 0.044715f * x * x) * 2.302208198144325f; return x * frcp(1.f + fexp2(-u)); }
__device__ __forceinline__ f32x4 sigm4(f32x4 t) {
#pragma unroll
    for (int e = 0; e < 4; ++e) t[e] = fexp2(t[e]);
    t = t + 1.f;
#pragma unroll
    for (int e = 0; e < 4; ++e) t[e] = frcp(t[e]);
    return t; }
__device__ __forceinline__ f32x4 silu4(const f32x4 x) { return x * sigm4(x * -1.4426950408889634f); }
__device__ __forceinline__ f32x4 gelu4(const f32x4 x) { return x * sigm4((x * (x * x * 0.044715f + 1.f)) * -2.302208198144325f); }
__device__ __forceinline__ float log2_decay(int h) { const float x = __builtin_bit_cast(float, (unsigned)(122 - h) << 23); return -1.4426950408889634f * (x * (1.f + x * (0.5f + x * (0.3333333433f + x * (0.25f + x * 0.2f))))); }
__device__ __forceinline__ float ld_sc1(const float* p) { return __hip_atomic_load(p, __ATOMIC_RELAXED, __HIP_MEMORY_SCOPE_AGENT); }
typedef unsigned int ssq_t;
constexpr float SSQ_FIX = 4096.0f, SSQ_INV = 1.0f / 4096.0f;
__device__ __forceinline__ ssq_t ssq_fix(float s) { return (ssq_t)(s * SSQ_FIX); }
__device__ __forceinline__ float row_rstd(const ssq_t* ssq, int r) { const ssq_t v = __hip_atomic_load(ssq + r, __ATOMIC_RELAXED, __HIP_MEMORY_SCOPE_AGENT); return __builtin_amdgcn_rsqf((float)v * (SSQ_INV / 1024.0f) + 1e-6f); }
__device__ __forceinline__ u32x4 pack8(const f32x4& a, const f32x4& b) { u32x4 w; w.x = cvt_pk_bf16(a[0], a[1]); w.y = cvt_pk_bf16(a[2], a[3]); w.z = cvt_pk_bf16(b[0], b[1]); w.w = cvt_pk_bf16(b[2], b[3]); return w; }

struct PreSsq { ssq_t v[2][4]; };
struct PreNone { };
__device__ __forceinline__ void pre_ssq(PreSsq& p, const ssq_t* ssq, int row0) {
#pragma unroll
    for (int ai = 0; ai < 2; ++ai)
#pragma unroll
        for (int m = 0; m < 4; ++m) p.v[ai][m] = __hip_atomic_load(ssq + row0 + ai * 128 + m * 16, __ATOMIC_RELAXED, __HIP_MEMORY_SCOPE_AGENT);
}
__device__ __forceinline__ float rstd_of(ssq_t v) { return __builtin_amdgcn_rsqf((float)v * (SSQ_INV / 1024.0f) + 1e-6f); }
constexpr int DFF = 2816, DM = 1024, PW = 1024;
constexpr size_t SLAB_BYTES = (size_t)24 << 20, SLAB_E = SLAB_BYTES / 2;
constexpr unsigned H_PAD16 = (unsigned)(SLAB_BYTES - (size_t)4096 * DFF * 2), H_PAD8 = (unsigned)(SLAB_BYTES - (size_t)4096 * DFF);
__host__ __device__ __forceinline__ constexpr size_t hrow16(int r) { return (size_t)(r >> 12) * SLAB_E + (size_t)(r & 4095) * DFF; }
__host__ __device__ __forceinline__ constexpr size_t hrow8(int r) { return (size_t)(r >> 12) * SLAB_BYTES + (size_t)(r & 4095) * DFF; }
__host__ __device__ __forceinline__ constexpr size_t prow_off(int r) { return (size_t)(r >> 12) * SLAB_E + (size_t)(r & 4095) * PW; }
__host__ __device__ __forceinline__ constexpr size_t ptile(int r, int hd, int t) { return (size_t)(r >> 12) * SLAB_E + (size_t)4096 * PW + ((size_t)((((r >> 7) & 31) * 4 + hd) * 4 + t) << 14) + (size_t)(r & 127) * 128; }
constexpr int F8_MASK = 0xC;
constexpr float H8_SCALE = 8.0f, WD8_SCALE = 256.0f, X8_SCALE = 16.0f, WG8_SCALE = 256.0f;
constexpr int F8GU_MASK = 0x8;

struct EpiSwiglu {
    static constexpr bool PERM = true, AFTER_DRAIN = false;
    bf16_t* H; const ssq_t* ssq; int skip; int f8; float ascale;
    typedef PreSsq Pre;
    __device__ __forceinline__ void prefetch(Pre& p, const Unit& u, int wr, int fr) const { pre_ssq(p, ssq, u.pm * BM + wr * 64 + fr); }
    __device__ __forceinline__ void operator()(const f32x4 (&acc)[2][2][4][2], const Unit& u, int wr, int wc, int fr, int fq, const Pre& pre) const {
        if (skip) { asm volatile("" :: "v"(acc[0][0][0][0]), "v"(acc[1][1][3][1])); return; }
        const int row0 = u.pm * BM + wr * 64 + fr, col0 = u.pn * 128 + wc * 32 + 8 * fq;
        float rs[2][4];
#pragma unroll
        for (int ai = 0; ai < 2; ++ai)
#pragma unroll
            for (int m = 0; m < 4; ++m) rs[ai][m] = rstd_of(pre.v[ai][m]) * ascale;
#pragma unroll
        for (int ai = 0; ai < 2; ++ai)
#pragma unroll
            for (int m = 0; m < 4; ++m) {
                const float s = rs[ai][m], c = -1.4426950408889634f * s, q = f8 ? s * s * H8_SCALE : s * s; f32x4 h0, h1;
                {
                    const f32x4 g0 = acc[ai][0][m][0], g1 = acc[ai][0][m][1]; f32x4 t0 = g0 * c, t1 = g1 * c;
#pragma unroll
                    for (int e = 0; e < 4; ++e) { t0[e] = fexp2(t0[e]); t1[e] = fexp2(t1[e]); }
                    t0 = t0 + 1.f; t1 = t1 + 1.f;
#pragma unroll
                    for (int e = 0; e < 4; ++e) { t0[e] = frcp(t0[e]); t1[e] = frcp(t1[e]); }
                    h0 = (g0 * acc[ai][1][m][0]) * (t0 * q); h1 = (g1 * acc[ai][1][m][1]) * (t1 * q); }
                if (f8) {
#pragma unroll
                    for (int e = 0; e < 4; ++e) { h0[e] = __builtin_fminf(__builtin_fmaxf(h0[e], -448.f), 448.f); h1[e] = __builtin_fminf(__builtin_fmaxf(h1[e], -448.f), 448.f); }
                    int w0 = 0, w1 = 0;
                    w0 = __builtin_amdgcn_cvt_pk_fp8_f32(h0[0], h0[1], w0, false); w0 = __builtin_amdgcn_cvt_pk_fp8_f32(h0[2], h0[3], w0, true);
                    w1 = __builtin_amdgcn_cvt_pk_fp8_f32(h1[0], h1[1], w1, false); w1 = __builtin_amdgcn_cvt_pk_fp8_f32(h1[2], h1[3], w1, true);
                    typedef int i32x2 __attribute__((ext_vector_type(2)));
                    *(i32x2*)((unsigned char*)H + hrow8(row0 + ai * HALF + m * 16) + col0) = (i32x2){w0, w1};
                } else
                *(u32x4*)(H + hrow16(row0 + ai * HALF + m * 16) + col0) = pack8(h0, h1);
            }
    }
};

__device__ __forceinline__ f32x4 unpk_lo(const u32x4& w) { f32x4 r; r[0] = __builtin_bit_cast(float, w.x << 16); r[1] = __builtin_bit_cast(float, w.x & 0xffff0000u); r[2] = __builtin_bit_cast(float, w.y << 16); r[3] = __builtin_bit_cast(float, w.y & 0xffff0000u); return r; }
__device__ __forceinline__ f32x4 unpk_hi(const u32x4& w) { f32x4 r; r[0] = __builtin_bit_cast(float, w.z << 16); r[1] = __builtin_bit_cast(float, w.z & 0xffff0000u); r[2] = __builtin_bit_cast(float, w.w << 16); r[3] = __builtin_bit_cast(float, w.w & 0xffff0000u); return r; }
struct EpiResid {
    static constexpr bool PERM = true, AFTER_DRAIN = false;
    bf16_t* XB; ssq_t* ssq_out; float scale; unsigned char* X8;
    typedef PreNone Pre;
    __device__ __forceinline__ void prefetch(Pre&, const Unit&, int, int) const {}
    __device__ __forceinline__ void operator()(const f32x4 (&acc)[2][2][4][2], const Unit& u, int wr, int wc, int fr, int fq, const Pre&) const {
        const int row0 = u.pm * BM + wr * 64 + fr, col0 = u.pn * BM + wc * 32 + 8 * fq;
        u32x4 base[2][4][2];
#pragma unroll
        for (int ai = 0; ai < 2; ++ai)
#pragma unroll
            for (int m = 0; m < 4; ++m)
#pragma unroll
                for (int bj = 0; bj < 2; ++bj) base[ai][m][bj] = *(const u32x4*)(XB + (size_t)(row0 + ai * HALF + m * 16) * DM + col0 + bj * HALF);
#pragma unroll
        for (int ai = 0; ai < 2; ++ai)
#pragma unroll
            for (int m = 0; m < 4; ++m) {
                const int r = row0 + ai * HALF + m * 16; const size_t off = (size_t)r * DM + col0; float s = 0.f;
#pragma unroll
                for (int bj = 0; bj < 2; ++bj) {
                    const f32x4 x0 = unpk_lo(base[ai][m][bj]) + acc[ai][bj][m][0] * scale, x1 = unpk_hi(base[ai][m][bj]) + acc[ai][bj][m][1] * scale;
                    *(u32x4*)(XB + off + bj * HALF) = pack8(x0, x1);
                    if (X8) { int w0 = 0, w1 = 0;
                        w0 = __builtin_amdgcn_cvt_pk_fp8_f32(__builtin_fminf(__builtin_fmaxf(x0[0] * X8_SCALE, -448.f), 448.f), __builtin_fminf(__builtin_fmaxf(x0[1] * X8_SCALE, -448.f), 448.f), w0, false);
                        w0 = __builtin_amdgcn_cvt_pk_fp8_f32(__builtin_fminf(__builtin_fmaxf(x0[2] * X8_SCALE, -448.f), 448.f), __builtin_fminf(__builtin_fmaxf(x0[3] * X8_SCALE, -448.f), 448.f), w0, true);
                        w1 = __builtin_amdgcn_cvt_pk_fp8_f32(__builtin_fminf(__builtin_fmaxf(x1[0] * X8_SCALE, -448.f), 448.f), __builtin_fminf(__builtin_fmaxf(x1[1] * X8_SCALE, -448.f), 448.f), w1, false);
                        w1 = __builtin_amdgcn_cvt_pk_fp8_f32(__builtin_fminf(__builtin_fmaxf(x1[2] * X8_SCALE, -448.f), 448.f), __builtin_fminf(__builtin_fmaxf(x1[3] * X8_SCALE, -448.f), 448.f), w1, true);
                        typedef int i32x2 __attribute__((ext_vector_type(2)));
                        *(i32x2*)(X8 + off + bj * HALF) = (i32x2){w0, w1}; }
                    { const f32x4 sq = x0 * x0 + x1 * x1; s += (sq[0] + sq[1]) + (sq[2] + sq[3]); }
                }
                s += __shfl_xor(s, 16); s += __shfl_xor(s, 32);
                if (fq == 0) atomicAdd(ssq_out + r, ssq_fix(scale != 0.f ? s : 0.f));
            }
    }
};

struct EpiMix {
    static constexpr bool PERM = true, AFTER_DRAIN = false;
    bf16_t* P; const ssq_t* ssq; const float* vnorm;
    typedef PreSsq Pre;
    __device__ __forceinline__ void prefetch(Pre& p, const Unit& u, int wr, int fr) const { pre_ssq(p, ssq, u.pm * BM + wr * 64 + fr); }
    __device__ __forceinline__ void operator()(const f32x4 (&acc)[2][2][4][2], const Unit& u, int wr, int wc, int fr, int fq, const Pre& pre) const {
        const int pn = u.pn, row0 = u.pm * BM + wr * 64 + fr, cc = wc * 32 + 8 * fq;
        float rs[2][4];
#pragma unroll
        for (int ai = 0; ai < 2; ++ai)
#pragma unroll
            for (int m = 0; m < 4; ++m) rs[ai][m] = rstd_of(pre.v[ai][m]);
#define MIX_ROWS(...) _Pragma("unroll") for (int ai = 0; ai < 2; ++ai) _Pragma("unroll") for (int m = 0; m < 4; ++m) { const int r = row0 + ai * HALF + m * 16; const float s = rs[ai][m]; \
            f32x4 a0 = acc[ai][0][m][0] * s, a1 = acc[ai][0][m][1] * s, b0 = acc[ai][1][m][0] * s, b1 = acc[ai][1][m][1] * s; bf16_t* prow = P + prow_off(r); __VA_ARGS__ asm volatile("" ::: "memory"); }
        if (pn == 2) {
            MIX_ROWS( *(u32x4*)(prow + 512 + cc) = pack8(a0, a1); *(u32x4*)(prow + 512 + cc + 128) = pack8(b0, b1); )
        } else if (pn == 9 || pn == 10) {
            const int hd = 2 * (pn - 9);
            MIX_ROWS( *(u32x4*)(P + ptile(r, hd, 2) + cc) = pack8(a0, a1); *(u32x4*)(P + ptile(r, hd + 1, 2) + cc) = pack8(b0, b1); )
        } else if (pn == 0) {
            MIX_ROWS( a0 = gelu4(a0); a1 = gelu4(a1); b0 = gelu4(b0); b1 = gelu4(b1);
                      *(u32x4*)(prow + cc) = pack8(a0, a1); *(u32x4*)(prow + cc + 128) = pack8(b0, b1); )
        } else if (pn == 11 || pn == 12) {
            const int hd = 2 * (pn - 11);
            MIX_ROWS( a0 = silu4(a0); a1 = silu4(a1); b0 = silu4(b0); b1 = silu4(b1);
                      *(u32x4*)(P + ptile(r, hd, 3) + cc) = pack8(a0, a1); *(u32x4*)(P + ptile(r, hd + 1, 3) + cc) = pack8(b0, b1); )
        } else if (pn == 1) {
            const int ch0 = 64 * wc + 8 * fq;
            const f32x4 g0 = *(const f32x4*)(vnorm + ch0), g1 = *(const f32x4*)(vnorm + ch0 + 4), g2 = *(const f32x4*)(vnorm + ch0 + 32), g3 = *(const f32x4*)(vnorm + ch0 + 36);
            MIX_ROWS( float s1 = 0.f;
                      a0 = gelu4(a0); a1 = gelu4(a1); b0 = gelu4(b0); b1 = gelu4(b1); { const f32x4 sv = (a0 + a1) + (b0 + b1); s1 = (sv[0] + sv[1]) + (sv[2] + sv[3]); }
                      s1 += __shfl_xor(s1, 16); s1 += __shfl_xor(s1, 32); const float mu = s1 * (1.0f / 64.0f); float s2 = 0.f;
                      a0 = a0 - mu; a1 = a1 - mu; b0 = b0 - mu; b1 = b1 - mu;
                      { const f32x4 qv = (a0 * a0 + a1 * a1) + (b0 * b0 + b1 * b1); s2 = (qv[0] + qv[1]) + (qv[2] + qv[3]); }
                      s2 += __shfl_xor(s2, 16); s2 += __shfl_xor(s2, 32); const float rv = __builtin_amdgcn_rsqf(s2 * (1.0f / 64.0f) + 1e-6f);
                      a0 = a0 * rv * g0; a1 = a1 * rv * g1; b0 = b0 * rv * g2; b1 = b1 * rv * g3;
                      *(u32x4*)(prow + 256 + ch0) = pack8(a0, a1); *(u32x4*)(prow + 256 + ch0 + 32) = pack8(b0, b1); )
        } else if (pn == 3 || pn == 4) {
            const int dst = 768 + 128 * (pn - 3) + cc;
            MIX_ROWS( a0 = a0 * b0; a1 = a1 * b1; *(u32x4*)(prow + dst) = pack8(a0, a1); )
        } else {
            const bool isk = pn >= 7; const int hd = 2 * ((pn - 5) & 1) + (wc >> 1), i0 = 32 * (wc & 1) + 8 * fq;
            const float lg = log2_decay(hd);
            const float lgs = isk ? -lg : lg; const int tq = isk ? 1 : 0;
            int rl = row0; asm volatile("" : "+v"(rl));
            float fi[8];
#pragma unroll
            for (int j = 0; j < 8; ++j) fi[j] = fexp2((float)((rl - row0) + i0 + j) * (-13.287712379549449f / 64.0f)) * 0.15915494309189535f;
            MIX_ROWS( const int rr = rl + ai * HALF + m * 16; const float fp = (float)(rr & 2047); const float sc = fexp2((float)(rr & 127) * lgs);
                      f32x4 c0, c1, s0, s1;
                      _Pragma("unroll") for (int e = 0; e < 4; ++e) { const float t0 = __builtin_amdgcn_fractf(fp * fi[e]), t1 = __builtin_amdgcn_fractf(fp * fi[4 + e]);
                          c0[e] = __builtin_amdgcn_cosf(t0); s0[e] = __builtin_amdgcn_sinf(t0); c1[e] = __builtin_amdgcn_cosf(t1); s1[e] = __builtin_amdgcn_sinf(t1); }
                      c0 = c0 * sc; s0 = s0 * sc; c1 = c1 * sc; s1 = s1 * sc;
                      const f32x4 o0 = a0 * c0 - b0 * s0, o1 = a1 * c1 - b1 * s1, p0 = b0 * c0 + a0 * s0, p1 = b1 * c1 + a1 * s1;
                      bf16_t* pq = P + ptile(r, hd, tq) + i0; *(u32x4*)pq = pack8(o0, o1); *(u32x4*)(pq + 64) = pack8(p0, p1); )
        }
#undef MIX_ROWS
    }
};

struct EpiSilu {
    static constexpr bool PERM = true, AFTER_DRAIN = false;
    bf16_t* P; const ssq_t* ssq; int dst0;
    typedef PreSsq Pre;
    __device__ __forceinline__ void prefetch(Pre& p, const Unit& u, int wr, int fr) const { pre_ssq(p, ssq, u.pm * BM + wr * 64 + fr); }
    __device__ __forceinline__ void operator()(const f32x4 (&acc)[2][2][4][2], const Unit& u, int wr, int wc, int fr, int fq, const Pre& pre) const {
        const int row0 = u.pm * BM + wr * 64 + fr, cc = wc * 32 + 8 * fq;
        float rs[2][4];
#pragma unroll
        for (int ai = 0; ai < 2; ++ai)
#pragma unroll
            for (int m = 0; m < 4; ++m) rs[ai][m] = rstd_of(pre.v[ai][m]);
#pragma unroll
        for (int ai = 0; ai < 2; ++ai)
#pragma unroll
            for (int m = 0; m < 4; ++m) { const float s = rs[ai][m]; const int r = row0 + ai * HALF + m * 16;
#pragma unroll
                for (int bj = 0; bj < 2; ++bj) { f32x4 a0 = acc[ai][bj][m][0] * s, a1 = acc[ai][bj][m][1] * s;
                    a0 = silu4(a0); a1 = silu4(a1);
                    *(u32x4*)(P + ptile(r, dst0 + bj, 3) + cc) = pack8(a0, a1); } }
    }
};

#ifndef F8_DEBUG32
#define F8_DEBUG32 0
#endif
template <class Epi, class Sched, bool ALIGN_EPI = false, bool SP2 = false, bool F8 = false  >
__device__ __forceinline__ void gemm_phase(PG8_LAS unsigned char* lds, const Gemm g, const Sched& S, const Epi& E, const int tid  ) {
    const int wid = __builtin_amdgcn_readfirstlane(tid >> 6), lane = tid & 63, wr = wid >> 2, wc = wid & 3, fr = lane & 15, fq = lane >> 4;
    const int K = g.K, nt = K / BK;
    unsigned voffA[2], voffB[2];
#pragma unroll
    for (int i = 0; i < 2; ++i) { int R, C; stage_rc(tid * 16 + i * 8192, R, C); const int Rb = Epi::PERM ? ((R & ~31) + perm32(R & 31)) : R;
        voffA[i] = (unsigned)(R * K + C) * 2u; voffB[i] = (unsigned)(Rb * K + C) * 2u; }
    const size_t kstep = (size_t)(BK * 2);
    const size_t hstep = (size_t)HALF * K * 2;
    const size_t tstep = 2 * hstep;
    const unsigned ldsw = (unsigned)wid * 1024u;
    const int aoff = lds_byte(wr * 64 + fr, fq * 8), boff = lds_byte(wc * 32 + fr, fq * 8);
#define PG8_SA(b, h) (((b) * 2 + (h)) * HTB)
#define PG8_SB(b, h) ((4 + (b) * 2 + (h)) * HTB)
#define PG8_STAGE(bufoff, gbase, voff) do { _Pragma("unroll") for (int _i = 0; _i < 2; ++_i) \
        __builtin_amdgcn_global_load_lds((const unsigned*)((const char*)(gbase) + (voff)[_i]), (PG8_LAS unsigned*)(lds + (bufoff) + ldsw + _i * 8192), 16, 0, 0); } while (0)
#define PG8_LDA(dst, b, h) do { _Pragma("unroll") for (int m = 0; m < 4; ++m) _Pragma("unroll") for (int k = 0; k < 2; ++k) dst[m][k] = *(const PG8_LAS bf16x8*)(lds + PG8_SA(b, h) + aoff + m * 2048 + k * 1024); } while (0)
#define PG8_LDB(dst, b, h) do { _Pragma("unroll") for (int n = 0; n < 2; ++n) _Pragma("unroll") for (int k = 0; k < 2; ++k) dst[n][k] = *(const PG8_LAS bf16x8*)(lds + PG8_SB(b, h) + boff + n * 2048 + k * 1024); } while (0)
#define PG8_MMA(ai, bj, At, Bt) do { __builtin_amdgcn_s_setprio(1); if constexpr (F8) { _Pragma("unroll") for (int m = 0; m < 4; ++m) _Pragma("unroll") for (int n = 0; n < 2; ++n) { \
        const i32x8 b8_ = __builtin_shufflevector(__builtin_bit_cast(i32x4, Bt[n][0]), __builtin_bit_cast(i32x4, Bt[n][1]), 0, 1, 2, 3, 4, 5, 6, 7), a8_ = __builtin_shufflevector(__builtin_bit_cast(i32x4, At[m][0]), __builtin_bit_cast(i32x4, At[m][1]), 0, 1, 2, 3, 4, 5, 6, 7); \
        if (F8_DEBUG32) { typedef long i64x4 __attribute__((ext_vector_type(4))); const i64x4 bl = __builtin_bit_cast(i64x4, b8_), al = __builtin_bit_cast(i64x4, a8_); \
            _Pragma("unroll") for (int q = 0; q < 4; ++q) acc[ai][bj][m][n] = __builtin_amdgcn_mfma_f32_16x16x32_fp8_fp8(bl[q], al[q], acc[ai][bj][m][n], 0, 0, 0); } \
        else asm volatile("v_mfma_scale_f32_16x16x128_f8f6f4 %0, %1, %2, %0, %3, %3 op_sel_hi:[0,0,0]" : "+v"(acc[ai][bj][m][n]) : "v"(b8_), "v"(a8_), "v"(f8scale)); } }     \
      else { _Pragma("unroll") for (int m = 0; m < 4; ++m) _Pragma("unroll") for (int n = 0; n < 2; ++n) _Pragma("unroll") for (int k = 0; k < 2; ++k) \
        acc[ai][bj][m][n] = __builtin_amdgcn_mfma_f32_16x16x32_bf16(Bt[n][k], At[m][k], acc[ai][bj][m][n], 0, 0, 0); } __builtin_amdgcn_s_setprio(0); } while (0)
#define PG8_WAIT_V(n) asm volatile("s_waitcnt vmcnt(" #n ")" ::: "memory")
#define PG8_WAIT_L(n) asm volatile("s_waitcnt lgkmcnt(" #n ")" ::: "memory")
#define PG8_BAR __builtin_amdgcn_s_barrier()
#define PG8_SCHED __builtin_amdgcn_sched_barrier(0)
    Unit cur, nxt; int ui = 0;
    if (!S.next(0, cur)) return;
    f32x4 acc[2][2][4][2];
    int f8scale = 0x7f7f7f7f; if constexpr (F8) asm volatile("" : "+v"(f8scale));
    typename Epi::Pre pre;
#pragma unroll
    for (int a = 0; a < 2; ++a)
#pragma unroll
        for (int b = 0; b < 2; ++b)
#pragma unroll
            for (int m = 0; m < 4; ++m)
#pragma unroll
                for (int n = 0; n < 2; ++n) acc[a][b][m][n] = (f32x4){0.f, 0.f, 0.f, 0.f};
    bf16x8 At[4][2], B0[2][2], B1[2][2];
    const char* cA = (const char*)g.A + (size_t)cur.pm * tstep + (size_t)(cur.pm >> 4) * g.a_pad; const char* cB = (const char*)g.Bt + (size_t)cur.pn * tstep;
    S.a_ready(cur);
    if constexpr (SP2) {
        PG8_STAGE(PG8_SB(0, 0), cB, voffB); PG8_STAGE(PG8_SB(0, 1), cB + hstep, voffB); PG8_STAGE(PG8_SA(0, 0), cA, voffA); PG8_STAGE(PG8_SA(0, 1), cA + hstep, voffA);
        PG8_STAGE(PG8_SB(1, 0), cB + kstep, voffB); PG8_STAGE(PG8_SA(1, 0), cA + kstep, voffA); PG8_STAGE(PG8_SB(1, 1), cB + hstep + kstep, voffB);
        if (wr == 1) PG8_BAR;
        PG8_WAIT_V(8); PG8_BAR;
        PG8_WAIT_V(6); PG8_BAR;
    } else {
        PG8_STAGE(PG8_SB(0, 0), cB, voffB); PG8_STAGE(PG8_SA(0, 0), cA, voffA); PG8_STAGE(PG8_SB(0, 1), cB + hstep, voffB); PG8_STAGE(PG8_SA(0, 1), cA + hstep, voffA);
        if (wr == 1) PG8_BAR;
        PG8_WAIT_V(4); PG8_BAR;
        PG8_STAGE(PG8_SB(1, 0), cB + kstep, voffB); PG8_STAGE(PG8_SA(1, 0), cA + kstep, voffA); PG8_STAGE(PG8_SB(1, 1), cB + hstep + kstep, voffB);
        PG8_WAIT_V(6); PG8_BAR;
    }
    for (;;) {
        const bool has_next = S.next(ui + 1, nxt);
        const char* nA = has_next ? (const char*)g.A + (size_t)nxt.pm * tstep + (size_t)(nxt.pm >> 4) * g.a_pad : cA; const char* nB = has_next ? (const char*)g.Bt + (size_t)nxt.pn * tstep : cB;
        for (int t = 0; t < nt; t += 2) {
            const bool last = (t == nt - 2);
            const char* a1 = cA + (size_t)(t + 1) * kstep;
            const char* a2 = last ? nA : cA + (size_t)(t + 2) * kstep; const char* b2 = last ? nB : cB + (size_t)(t + 2) * kstep;
            const char* a3 = a2 + kstep; const char* b3 = b2 + kstep;
            if (last && has_next) S.a_ready(nxt);
            if (last) E.prefetch(pre, cur, wr, fr);
            if constexpr (SP2) {
            PG8_LDB(B0, 0, 0); PG8_LDB(B1, 0, 1); PG8_SCHED; PG8_LDA(At, 0, 0); PG8_STAGE(PG8_SA(1, 1), a1 + hstep, voffA);
            PG8_WAIT_V(8); PG8_WAIT_L(0); PG8_BAR; PG8_MMA(0, 0, At, B0); PG8_MMA(0, 1, At, B1); PG8_BAR; PG8_SCHED;
            PG8_LDA(At, 0, 1); PG8_STAGE(PG8_SB(0, 0), b2, voffB); PG8_STAGE(PG8_SB(0, 1), b2 + hstep, voffB); PG8_STAGE(PG8_SA(0, 0), a2, voffA);
            PG8_WAIT_V(8); PG8_WAIT_L(0); PG8_BAR; PG8_MMA(1, 0, At, B0); PG8_MMA(1, 1, At, B1); PG8_BAR; PG8_SCHED;
            PG8_LDB(B0, 1, 0); PG8_LDB(B1, 1, 1); PG8_SCHED; PG8_LDA(At, 1, 0); PG8_STAGE(PG8_SA(0, 1), a2 + hstep, voffA);
            PG8_WAIT_V(8); PG8_WAIT_L(0); PG8_BAR; PG8_MMA(0, 0, At, B0); PG8_MMA(0, 1, At, B1); PG8_BAR; PG8_SCHED;
            PG8_LDA(At, 1, 1); PG8_STAGE(PG8_SB(1, 0), b3, voffB); PG8_STAGE(PG8_SB(1, 1), b3 + hstep, voffB); PG8_STAGE(PG8_SA(1, 0), a3, voffA);
            PG8_WAIT_V(8); PG8_WAIT_L(0); PG8_BAR; PG8_MMA(1, 0, At, B0); PG8_MMA(1, 1, At, B1); PG8_BAR; PG8_SCHED;
            } else {
            PG8_LDB(B0, 0, 0); PG8_SCHED; PG8_LDA(At, 0, 0); PG8_STAGE(PG8_SA(1, 1), a1 + hstep, voffA);
            PG8_WAIT_L(8); PG8_BAR; PG8_WAIT_L(0); PG8_MMA(0, 0, At, B0); PG8_BAR; PG8_SCHED;
            PG8_LDB(B1, 0, 1); PG8_STAGE(PG8_SB(0, 0), b2, voffB);
            PG8_BAR; PG8_WAIT_L(0); PG8_MMA(0, 1, At, B1); PG8_BAR;
            PG8_LDA(At, 0, 1); PG8_STAGE(PG8_SA(0, 0), a2, voffA);
            PG8_BAR; PG8_WAIT_L(0); PG8_MMA(1, 0, At, B0); PG8_BAR; PG8_SCHED;
            PG8_STAGE(PG8_SB(0, 1), b2 + hstep, voffB);
            PG8_WAIT_V(6); PG8_BAR; PG8_MMA(1, 1, At, B1); PG8_BAR;
            PG8_LDB(B0, 1, 0); PG8_SCHED; PG8_LDA(At, 1, 0); PG8_STAGE(PG8_SA(0, 1), a2 + hstep, voffA);
            PG8_WAIT_L(8); PG8_BAR; PG8_WAIT_L(0); PG8_MMA(0, 0, At, B0); PG8_BAR; PG8_SCHED;
            PG8_LDB(B1, 1, 1); PG8_STAGE(PG8_SB(1, 0), b3, voffB);
            PG8_BAR; PG8_WAIT_L(0); PG8_MMA(0, 1, At, B1); PG8_BAR;
            PG8_LDA(At, 1, 1); PG8_STAGE(PG8_SA(1, 0), a3, voffA);
            PG8_BAR; PG8_WAIT_L(0); PG8_MMA(1, 0, At, B0); PG8_BAR; PG8_SCHED;
            PG8_STAGE(PG8_SB(1, 1), b3 + hstep, voffB);
            PG8_WAIT_V(6); PG8_BAR; PG8_MMA(1, 1, At, B1); PG8_BAR;
            }
        }
        if constexpr (ALIGN_EPI) { if (wr == 0) PG8_BAR; }
        if constexpr (F8) asm volatile("s_nop 15\n\ts_nop 15" ::: "memory");
        if constexpr (!Epi::AFTER_DRAIN) { E(acc, cur, wr, wc, fr, fq, pre); S.done(cur); }
        if (!has_next) break;
#pragma unroll
        for (int a = 0; a < 2; ++a)
#pragma unroll
            for (int b = 0; b < 2; ++b)
#pragma unroll
                for (int m = 0; m < 4; ++m)
#pragma unroll
                    for (int n = 0; n < 2; ++n) acc[a][b][m][n] = (f32x4){0.f, 0.f, 0.f, 0.f};
        cur = nxt; cA = nA; cB = nB; ++ui;
        if constexpr (ALIGN_EPI) { if (wr == 1) PG8_BAR; }
    }
    PG8_WAIT_V(0);
    if constexpr (!ALIGN_EPI) { if (wr == 0) PG8_BAR; }
    PG8_BAR;
    if constexpr (Epi::AFTER_DRAIN) { E.fused(acc, cur, wr, wc, fr, fq, lds, wid, lane); S.done(cur); }
#undef PG8_SA
#undef PG8_SB
#undef PG8_STAGE
#undef PG8_LDA
#undef PG8_LDB
#undef PG8_MMA
#undef PG8_WAIT_V
#undef PG8_WAIT_L
#undef PG8_BAR
#undef PG8_SCHED
}
}
#define GAS __attribute__((address_space(1)))
#define LAS __attribute__((address_space(3)))
typedef unsigned short bf16;
typedef unsigned v4u __attribute__((ext_vector_type(4)));
typedef float f32x4 __attribute__((ext_vector_type(4)));
typedef short bf16x8 __attribute__((ext_vector_type(8)));
typedef GAS unsigned gu32;
typedef GAS unsigned long long gu64;
#define RLX_AGENT __ATOMIC_RELAXED, __HIP_MEMORY_SCOPE_AGENT
#define LDS_WAIT() asm volatile("s_waitcnt lgkmcnt(0)" ::: "memory")
#define VM_WAIT() asm volatile("s_waitcnt vmcnt(0)" ::: "memory")
__device__ __forceinline__ unsigned long long rt() { return __builtin_amdgcn_s_memrealtime(); }
__device__ __forceinline__ unsigned f2bf(float f) { unsigned u = __builtin_bit_cast(unsigned, f); return (u + 0x7fffu + ((u >> 16) & 1u)) >> 16; }
__device__ __forceinline__ unsigned pk2(float lo, float hi) { return f2bf(lo) | (f2bf(hi) << 16); }
#define XB_TMO      128
#define XB_XCNT(j)  (256  + 64 * (j))
#define XB_XSUB(j)  (1280 + 64 * (j))
#define XB_XGEN(j)  (2304 + 64 * (j))
#define XB_TOP      3328
#define XB_TOPGEN   3392
#define XCD_BAR_WORDS 3456
#define XB_SPIN_CAP (1u << 18)

__device__ __forceinline__ unsigned xb_ld(unsigned* p)              { return __hip_atomic_load(p, __ATOMIC_RELAXED, __HIP_MEMORY_SCOPE_AGENT); }
__device__ __forceinline__ unsigned xb_add(unsigned* p, unsigned v) { return __hip_atomic_fetch_add(p, v, __ATOMIC_RELAXED, __HIP_MEMORY_SCOPE_AGENT); }
__device__ __forceinline__ unsigned xb_xcc_id() { return (unsigned)__builtin_amdgcn_s_getreg((3 << 11) | 20) & 0xFu; }
#define XB_SPIN(cond, bar) do { unsigned _sp = 0; while (cond) { __builtin_amdgcn_s_sleep(1); \
    if ((++_sp & 255u) == 0u) { if (xb_ld(&(bar)[XB_TMO])) break; if (_sp > XB_SPIN_CAP) { atomicAdd(&(bar)[XB_TMO], 1u); break; } } } } while (0)

struct XcdBarrier {
    unsigned* bar; unsigned x;
    volatile LAS unsigned* st;
};

__device__ __forceinline__ XcdBarrier xcd_barrier_post(unsigned* bar, volatile LAS unsigned* st) {
    XcdBarrier b; b.bar = bar; b.x = xb_xcc_id(); b.st = st;
    if (threadIdx.x == 0) st[2] = xb_add(&bar[XB_XCNT(b.x)], 1u);
    return b;
}
__device__ __forceinline__ void xcd_barrier_complete(unsigned* bar, unsigned x, unsigned& nloc, unsigned& nx, unsigned& even) {
    const unsigned G = gridDim.x * gridDim.y * gridDim.z;
    unsigned sum, cnt, mine, sp = 0u, ev;
    for (;;) {
        sum = 0u; cnt = 0u; mine = 0u; ev = 1u;
#pragma unroll
        for (unsigned j = 0; j < 16; ++j) { const unsigned c = xb_ld(&bar[XB_XCNT(j)]); sum += c; cnt += (c > 0u) ? 1u : 0u; mine = (j == x) ? c : mine; ev &= (c == (j < 8u ? G / 8u : 0u)) ? 1u : 0u; }
        if (sum == G) break;
        __builtin_amdgcn_s_sleep(1);
        if ((++sp & 255u) == 0u) { if (xb_ld(&bar[XB_TMO])) break; if (sp > XB_SPIN_CAP) { atomicAdd(&bar[XB_TMO], 1u); break; } }
    }
    nloc = mine > 0u ? mine : 1u; nx = cnt > 0u ? cnt : 1u; even = (sum == G && (G & 7u) == 0u) ? ev : 0u;
}

__device__ __forceinline__ void xcd_barrier(const XcdBarrier& b) {
    asm volatile("s_waitcnt vmcnt(0)" ::: "memory");
    __syncthreads();
    if (threadIdx.x == 0) {
        unsigned* bar = b.bar;
        __builtin_amdgcn_s_waitcnt(0);
        unsigned nloc = b.st[0], nx = b.st[1];
        if (nloc == 0u) { unsigned even; xcd_barrier_complete(bar, b.x, nloc, nx, even); b.st[0] = nloc; b.st[1] = nx; b.st[3] = even; }
        const unsigned old = xb_add(&bar[XB_XSUB(b.x)], 1u);
        const unsigned gen = old / nloc;
        if (old + 1u == (gen + 1u) * nloc) {
            __builtin_amdgcn_fence(__ATOMIC_RELEASE, "agent");
            asm volatile("s_waitcnt vmcnt(0)" ::: "memory");
            const unsigned og = xb_add(&bar[XB_TOP], 1u);
            const unsigned tg = og / nx;
            if (og + 1u == (tg + 1u) * nx) xb_add(&bar[XB_TOPGEN], 1u);
            else XB_SPIN(xb_ld(&bar[XB_TOPGEN]) == tg, bar);
            __builtin_amdgcn_fence(__ATOMIC_ACQUIRE, "agent");
            xb_add(&bar[XB_XGEN(b.x)], 1u);
            asm volatile("s_waitcnt vmcnt(0)" ::: "memory");
        } else {
            XB_SPIN(xb_ld(&bar[XB_XGEN(b.x)]) == gen, bar);
            __builtin_amdgcn_fence(__ATOMIC_ACQUIRE, "agent");
            asm volatile("s_waitcnt vmcnt(0)" ::: "memory");
        }
    }
    __syncthreads();
}

#define XB_LSUB(j) (64 * (int)(j) - 4096)
__device__ __forceinline__ void xcd_barrier_local(const XcdBarrier& b) {
    asm volatile("s_waitcnt vmcnt(0)" ::: "memory");
    __syncthreads();
    if (threadIdx.x == 0) {
        unsigned* bar = b.bar;
        __builtin_amdgcn_s_waitcnt(0);
        const unsigned nloc = b.st[0];
        const unsigned k = b.st[6] + 1u; b.st[6] = k;
        __builtin_amdgcn_fence(__ATOMIC_ACQUIRE, "agent");
        (void)__hip_atomic_fetch_add(&bar[XB_LSUB(b.x)], 1u, __ATOMIC_RELAXED, __HIP_MEMORY_SCOPE_AGENT);
        XB_SPIN(xb_ld(&bar[XB_LSUB(b.x)]) < k * nloc, bar);
        asm volatile("s_waitcnt vmcnt(0)" ::: "memory");
    }
    __syncthreads();
}
constexpr int NWAVES = 8;
#ifndef MK_N_LAUNCHES
#define MK_N_LAUNCHES 1
#endif
constexpr int N_PHASES = 18;
#ifndef PH_ENABLE
#define PH_ENABLE 0x1ff
#endif
#define EN(x) (((PH_ENABLE) >> (x)) & 1)
#ifndef DUP_MASK
#define DUP_MASK 0
#endif
#ifndef TAIL_SPLIT
#define TAIL_SPLIT 1
#endif
#ifndef PROBE_SKIP_EPI
#define PROBE_SKIP_EPI 0
#endif
#define NREP(x) ((((DUP_MASK) >> (x)) & 1) ? 2 : 1)
constexpr int N_LAUNCHES = MK_N_LAUNCHES;

constexpr int BATCH = 16, SEQ = 2048, D = 1024, M = BATCH * SEQ, FF = 2816, NGU = 2 * FF, NPROJ = 3328, PW = pg8::PW, CHUNK = 128, NCH = SEQ / CHUNK, NHEAD = 4;
constexpr float EPS = 1e-6f;
constexpr int TAIL_WGS = M / 256, NSHARE = 256;
constexpr int RET_WGS = BATCH * NHEAD;

constexpr size_t MiB = 1u << 20;
constexpr size_t WS_CTL = 0, CTL_ZERO_BYTES = 32768;
constexpr size_t WS_SSQ = 1 * MiB;
constexpr size_t WS_COS = 2 * MiB, WS_SIN = 2 * MiB + 512 * 1024;
constexpr size_t WS_WTRIL = 3 * MiB;
constexpr size_t WS_W = 4 * MiB;
constexpr size_t W_GU = (size_t)NGU * D * 2, W_DN = (size_t)D * FF * 2, W_IN = (size_t)NPROJ * D * 2, W_OUT = (size_t)D * D * 2;
constexpr size_t WO_GU1 = 0, WO_D1 = WO_GU1 + W_GU, WO_IN = WO_D1 + W_DN, WO_OUT = WO_IN + W_IN, WO_GU2 = WO_OUT + W_OUT, WO_D2 = WO_GU2 + W_GU, W_LAYER = WO_D2 + W_DN;
static_assert(WS_W + 2 * W_LAYER <= 88 * MiB, "weights");
constexpr size_t WS_XB = 88 * MiB;
constexpr size_t WS_HP = 152 * MiB;
constexpr size_t WS_Y = 344 * MiB;
constexpr size_t WS_PT = 408 * MiB;
constexpr size_t WS_X8 = 440 * MiB;
constexpr size_t WS_END = 472 * MiB;
constexpr int CW_BAR = 4096;
static_assert((CW_BAR + XCD_BAR_WORDS) * 4 <= (int)CTL_ZERO_BYTES && CTL_ZERO_BYTES % 16 == 0, "the barrier words sit inside the per-call memset");

constexpr int RING_OFF = 0, RING_BYTES = 131072;
constexpr int TILE_LD = 272, TILE_BYTES = 128 * TILE_LD;
constexpr int SCR_BYTES = 4 * TILE_BYTES;
constexpr int LDSCTL_OFF = SCR_BYTES, MISC_OFF = LDSCTL_OFF + 320;
constexpr int LDS_BYTES = 147456;
static_assert(MISC_OFF + 128 <= LDS_BYTES && RING_BYTES <= SCR_BYTES, "LDS map");

typedef unsigned short u16x4 __attribute__((ext_vector_type(4)));
typedef unsigned u32x2 __attribute__((ext_vector_type(2)));
#define MFMA16(a, b, c) __builtin_amdgcn_mfma_f32_16x16x32_bf16((a), (b), (c), 0, 0, 0)
typedef short s16x4 __attribute__((ext_vector_type(4)));
template <int LD> __device__ __forceinline__ bf16x8 tr_frag(unsigned addr) {
    const s16x4 lo = __builtin_amdgcn_ds_read_tr16_b64_v4i16((LAS s16x4*)(uintptr_t)addr), hi = __builtin_amdgcn_ds_read_tr16_b64_v4i16((LAS s16x4*)(uintptr_t)(addr + 4 * LD));
    return __builtin_shufflevector(lo, hi, 0, 1, 2, 3, 4, 5, 6, 7);
}
__device__ __forceinline__ float bf2f(unsigned short h) { return __builtin_bit_cast(float, (unsigned)h << 16); }
__device__ __forceinline__ float bflo(unsigned w) { return __builtin_bit_cast(float, w << 16); }
__device__ __forceinline__ float bfhi(unsigned w) { return __builtin_bit_cast(float, w & 0xffff0000u); }
template <int NCOL, int LD> __device__ __forceinline__ void stage_tile(LAS unsigned char* dst, const bf16* src, int gpitch, int tid) {
    constexpr int CPR = NCOL / 8, NCHUNK = 128 * CPR;
#pragma unroll
    for (int i = 0; i < NCHUNK / 512; ++i) { const int c = tid + 512 * i, row = c / CPR, ch = c % CPR;
        const v4u v = *(const GAS v4u*)(src + (size_t)row * gpitch + ch * 8); *(LAS v4u*)(dst + row * LD + ch * 16) = v; }
}
__device__ __forceinline__ float wave_sum(float v) {
#pragma unroll
    for (int o = 1; o < 64; o <<= 1) v += __shfl_xor(v, o);
    return v;
}

struct TrDesc { const float* W; const float* gain; bf16* WT; int N, K, dst_row0, src_col0, k0; float cscale; int f8; };
__device__ __forceinline__ void tr_load(const TrDesc& d, float (&v)[32], int lane) {
    const int n = lane & 31, kh = d.k0 + 32 * (lane >> 5);
    const GAS float* src = (const GAS float*)(d.W + (size_t)kh * d.N + d.src_col0 + n);
#pragma unroll
    for (int i = 0; i < 32; ++i) v[i] = src[(size_t)i * d.N];
}
__device__ __forceinline__ void tr_store(const TrDesc& d, float (&v)[32], int lane) {
    const int n = lane & 31, kh = d.k0 + 32 * (lane >> 5);
    if (d.gain) {
#pragma unroll
        for (int j = 0; j < 8; ++j) { const f32x4 g = *(const GAS f32x4*)(d.gain + kh + 4 * j); v[4 * j] *= g[0]; v[4 * j + 1] *= g[1]; v[4 * j + 2] *= g[2]; v[4 * j + 3] *= g[3]; }
    }
    const float cs = d.cscale;
    if (d.f8) {
        GAS v4u* dst8 = (GAS v4u*)((unsigned char*)d.WT + (size_t)(d.dst_row0 + n) * d.K + kh);
#pragma unroll
        for (int j = 0; j < 2; ++j) { int w[4];
#pragma unroll
            for (int q = 0; q < 4; ++q) { w[q] = 0; w[q] = __builtin_amdgcn_cvt_pk_fp8_f32(v[16 * j + 4 * q] * cs, v[16 * j + 4 * q + 1] * cs, w[q], false); w[q] = __builtin_amdgcn_cvt_pk_fp8_f32(v[16 * j + 4 * q + 2] * cs, v[16 * j + 4 * q + 3] * cs, w[q], true); }
            dst8[j] = (v4u){(unsigned)w[0], (unsigned)w[1], (unsigned)w[2], (unsigned)w[3]}; }
        return;
    }
    GAS v4u* dst = (GAS v4u*)(d.WT + (size_t)(d.dst_row0 + n) * d.K + kh);
#pragma unroll
    for (int j = 0; j < 4; ++j) { v4u o; o.x = pk2(v[8 * j] * cs, v[8 * j + 1] * cs); o.y = pk2(v[8 * j + 2] * cs, v[8 * j + 3] * cs); o.z = pk2(v[8 * j + 4] * cs, v[8 * j + 5] * cs); o.w = pk2(v[8 * j + 6] * cs, v[8 * j + 7] * cs); dst[j] = o; }
}
__device__ __forceinline__ int win_src_col(int pn, int c) {
    switch (pn) {
        case 0: return c;
        case 1: return 256 + 64 * ((c >> 5) & 3) + 32 * (c >> 7);
        case 2: return 512 + c;
        case 3: case 4: return (c < 128 ? 768 : 1024 - 128) + 128 * (pn - 3) + c;
        case 5: case 6: { const int cp = c & 127; return 1280 + 128 * (2 * (pn - 5) + (cp >> 6)) + (c < 128 ? 0 : 64) + (cp & 63); }
        case 7: case 8: { const int cp = c & 127; return 1792 + 128 * (2 * (pn - 7) + (cp >> 6)) + (c < 128 ? 0 : 64) + (cp & 63); }
        case 9: case 10: return 2304 + 256 * (pn - 9) + c;
        default: return 2816 + 256 * (pn - 11) + c;
    }
}

__host__ __device__ __forceinline__ constexpr int inner_ks(int i) { return i < 8 ? 0 : i < 14 ? 1 : i < 18 ? 2 : 3; }
__host__ __device__ __forceinline__ constexpr int inner_tb(int i) { return i < 8 ? i : i < 14 ? i - 8 + 2 : i < 18 ? i - 14 + 4 : i - 18 + 6; }
struct Args { const float* in[18]; float* out; unsigned char* ws; int ph_lo, ph_hi, li, pad; };
typedef Args __attribute__((address_space(4))) CArgs;

__global__ void __launch_bounds__(NWAVES * 64, 2) fwd_kernel(Args args0) {
    extern __shared__ __attribute__((aligned(16))) unsigned char lds_raw[];
    LAS unsigned char* lds = (LAS unsigned char*)lds_raw;
    volatile LAS unsigned* MISC = (volatile LAS unsigned*)(lds + MISC_OFF);
    const int tid = threadIdx.x, wave = __builtin_amdgcn_readfirstlane(tid >> 6);
    const int G = gridDim.x, bid0 = blockIdx.x;
    const unsigned lds_base = (unsigned)(uintptr_t)lds;
    gu32* ctl = (gu32*)(args0.ws + WS_CTL);

    for (int u = tid; u < (LDS_BYTES - LDSCTL_OFF) / 4; u += NWAVES * 64) ((LAS unsigned*)(lds + LDSCTL_OFF))[u] = 0u;
    __syncthreads();
    if (tid == 0) MISC[12] = (unsigned)bid0;
    __syncthreads();
    XcdBarrier bar; bar.bar = (unsigned*)(ctl + CW_BAR); bar.x = 0; bar.st = nullptr;
    if (N_LAUNCHES == 1) bar = xcd_barrier_post((unsigned*)(ctl + CW_BAR), MISC + 8);
    const int lo = args0.ph_lo, hi = args0.ph_hi;
#define IN(k) (lo <= (k) && (k) < hi)
#define LAUNDER() const CArgs* ap_ = (const CArgs*)__builtin_amdgcn_kernarg_segment_ptr(); asm volatile("" : "+s"(ap_));     \
    const CArgs& args = *ap_; unsigned char* const ws = ap_->ws; pg8::ssq_t* const ssqb = (pg8::ssq_t*)(ws + WS_SSQ); bf16* const WTRIL = (bf16*)(ws + WS_WTRIL); unsigned char* const XB8 = ws + WS_X8; bf16* const XB = (bf16*)(ws + WS_XB); \
    bf16* const HP = (bf16*)(ws + WS_HP); bf16* const Y = (bf16*)(ws + WS_Y); bf16* const PT = (bf16*)(ws + WS_PT); (void)ssqb; (void)WTRIL; (void)XB8; (void)XB; (void)HP; (void)Y; (void)PT; (void)args; \
    int bidl_ = __builtin_amdgcn_readfirstlane((int)MISC[12]); asm volatile("" : "+s"(bidl_)); const int bid = bidl_;     \
    unsigned lz_ = 0u; asm volatile("" : "+v"(lz_)); int ptid = wave * 64 + (int)__builtin_amdgcn_mbcnt_hi(~0u, __builtin_amdgcn_mbcnt_lo(~0u, lz_));     const int lane = ptid & 63, l15 = lane & 15, q4 = lane >> 4, tq = l15 >> 2, tp = lane & 3; (void)l15; (void)q4; (void)tq; (void)tp; (void)lane
#ifndef PROBE_XBAR
#define PROBE_XBAR 0
#endif
#ifndef HELPER_PF
#define HELPER_PF 1
#endif
#ifndef LOCAL_SEAMS
#define LOCAL_SEAMS 1
#endif
#define SEAM(k) do { if (IN(k) && IN((k) + 1)) { \
        if ((k) == 0) { xcd_barrier(bar); if (N_LAUNCHES == 1) { if (tid == 0 && MISC[11]) MISC[12] = MISC[10] * 8u + bar.x; __syncthreads(); } } \
        else if (N_LAUNCHES == 1 && LOCAL_SEAMS && MISC[11]) xcd_barrier_local(bar); else xcd_barrier(bar); \
        if (PROBE_XBAR) { xcd_barrier(bar); xcd_barrier(bar); } } } while (0)

#define OWN_ROW0(bid_) (((bid_) & 7) * (M / 8) + ((bid_) >> 3) * (M / G))
    if (EN(0) && IN(0)) {
            for (int rep = 0; rep < NREP(0); ++rep) { LAUNDER();
        const int gw = bid * NWAVES + wave, NGW = G * NWAVES;
        constexpr int I_GU = (NGU / 32) * (D / 64), I_DN = (D / 32) * (FF / 64), I_IN = (NPROJ / 32) * (D / 64), I_OUT = (D / 32) * (D / 64), I_LAYER = 2 * I_GU + 2 * I_DN + I_IN + I_OUT;
#define TR_DECODE(it_, d_) do { const int l_ = (it_) / I_LAYER; int r_ = (it_) % I_LAYER; unsigned char* WL_ = ws + WS_W + (size_t)l_ * W_LAYER; \
            if (r_ < 2 * I_GU) { const int f_ = r_ / I_GU; r_ %= I_GU; const int kb_ = r_ / (NGU / 32), rb_ = r_ % (NGU / 32), pn_ = rb_ >> 3, cb_ = rb_ & 7;     \
                d_ = TrDesc{args.in[(f_ ? 14 : 2) + (cb_ >= 4 ? 1 : 0)] + (size_t)l_ * D * FF, args.in[f_ ? 13 : 1] + l_ * D, (bf16*)(WL_ + (f_ ? WO_GU2 : WO_GU1)), FF, D, rb_ * 32, 128 * pn_ + 32 * (cb_ & 3), kb_ * 64, ((pg8::F8GU_MASK >> (2 * l_ + f_)) & 1) ? pg8::WG8_SCALE : 1.f, (pg8::F8GU_MASK >> (2 * l_ + f_)) & 1}; } \
            else if ((r_ -= 2 * I_GU) < 2 * I_DN) { const int f_ = r_ / I_DN; r_ %= I_DN; const int kb_ = r_ / (D / 32), rb_ = r_ % (D / 32);                \
                d_ = TrDesc{args.in[f_ ? 16 : 4] + (size_t)l_ * FF * D, nullptr, (bf16*)(WL_ + (f_ ? WO_D2 : WO_D1)), D, FF, rb_ * 32, rb_ * 32, kb_ * 64, ((pg8::F8_MASK >> (2 * l_ + f_)) & 1) ? 0.5f * pg8::WD8_SCALE : 0.5f, (pg8::F8_MASK >> (2 * l_ + f_)) & 1}; } \
            else if ((r_ -= 2 * I_DN) < I_IN) { const int kb_ = r_ / (NPROJ / 32), rb_ = r_ % (NPROJ / 32), pn_ = rb_ >> 3, c_ = (rb_ & 7) * 32; \
                d_ = TrDesc{args.in[6] + (size_t)l_ * D * NPROJ, args.in[5] + l_ * D, (bf16*)(WL_ + WO_IN), NPROJ, D, rb_ * 32, win_src_col(pn_, c_), kb_ * 64, (pn_ == 7 || pn_ == 8) ? 0.08838834764831845f : 1.f, 0}; } \
            else { r_ -= I_IN; const int kb_ = r_ / (D / 32), rb_ = r_ % (D / 32); \
                d_ = TrDesc{args.in[12] + (size_t)l_ * D * D, nullptr, (bf16*)(WL_ + WO_OUT), D, D, rb_ * 32, rb_ * 32, kb_ * 64, 1.f, 0}; } } while (0)
        for (int it = gw; it < 2 * I_LAYER; it += 2 * NGW) {
            TrDesc d0, d1; float v0[32], v1[32]; const bool two = it + NGW < 2 * I_LAYER;
            TR_DECODE(it, d0); tr_load(d0, v0, lane);
            if (two) { TR_DECODE(it + NGW, d1); tr_load(d1, v1, lane); }
            tr_store(d0, v0, lane);
            if (two) tr_store(d1, v1, lane);
        }
#undef TR_DECODE
        const float* xin = args.in[0];
        for (int m0 = OWN_ROW0(bid) + 4 * wave; m0 < OWN_ROW0(bid) + M / G; m0 += 4 * NWAVES) {
            f32x4 v[4][4];
#pragma unroll
            for (int r = 0; r < 4; ++r) { const GAS f32x4* xr = (const GAS f32x4*)(xin + (size_t)(m0 + r) * D) + lane;
#pragma unroll
                for (int j = 0; j < 4; ++j) v[r][j] = xr[64 * j]; }
#pragma unroll
            for (int r = 0; r < 4; ++r) { float s = 0.f;
#pragma unroll
                for (int j = 0; j < 4; ++j) s += (v[r][j].x * v[r][j].x + v[r][j].y * v[r][j].y) + (v[r][j].z * v[r][j].z + v[r][j].w * v[r][j].w);
                s = wave_sum(s);
                GAS unsigned long long* o8 = (GAS unsigned long long*)(XB + (size_t)(m0 + r) * D) + lane;
#pragma unroll
                for (int j = 0; j < 4; ++j) o8[64 * j] = (unsigned long long)pk2(v[r][j].x, v[r][j].y) | ((unsigned long long)pk2(v[r][j].z, v[r][j].w) << 32);
                if (lane == 0) { __hip_atomic_store(ssqb + m0 + r, pg8::ssq_fix(s), RLX_AGENT); __hip_atomic_store(ssqb + M + m0 + r, (pg8::ssq_t)0, RLX_AGENT); } }
        }
        const int gt = bid * (NWAVES * 64) + ptid, NGT = G * NWAVES * 64;
        for (int i = gt; i < 2 * 4 * 128 * 128; i += NGT) { const int t = (i >> 7) & 127, s = i & 127; WTRIL[i] = (bf16)(s <= t ? f2bf(args.in[8][i]) : 0u); }
    }
        }
    SEAM(0);

    int ph = 1, cur = 0;
#pragma unroll 1
    for (int step = 0; step < 4; ++step) {
        const int l = step >> 1, f = step & 1;
#define WL (ws + WS_W + (size_t)l * W_LAYER)
        if (EN(1) && IN(ph)) {
            for (int rep = 0; rep < NREP(1); ++rep) { LAUNDER();
            if (ptid < 128) __hip_atomic_store(ssqb + (cur ^ 1) * M + OWN_ROW0(bid) + ptid, (pg8::ssq_t)0, RLX_AGENT);
            pg8::StaticOrder S; S.init(M, NGU, G, bid);
            if ((pg8::F8GU_MASK >> step) & 1) {
                pg8::Gemm g{(const bf16*)XB8, (const bf16*)(WL + (f ? WO_GU2 : WO_GU1)), M, NGU, D / 2};
                pg8::EpiSwiglu E{HP, ssqb + cur * M, (PROBE_SKIP_EPI && rep + 1 < NREP(1)) ? 1 : 0, ((pg8::F8_MASK >> step) & 1), 1.0f / (pg8::X8_SCALE * pg8::WG8_SCALE)};
                pg8::gemm_phase<pg8::EpiSwiglu, pg8::StaticOrder, true, true, true>(lds + RING_OFF, g, S, E, ptid);
            } else {
                pg8::Gemm g{XB, (const bf16*)(WL + (f ? WO_GU2 : WO_GU1)), M, NGU, D};
                pg8::EpiSwiglu E{HP, ssqb + cur * M, (PROBE_SKIP_EPI && rep + 1 < NREP(1)) ? 1 : 0, ((pg8::F8_MASK >> step) & 1), 1.0f};
                pg8::gemm_phase<pg8::EpiSwiglu, pg8::StaticOrder, true, true, false>(lds + RING_OFF, g, S, E, ptid);
            }
        }
        }
        SEAM(ph); ++ph;
        if (EN(2) && IN(ph)) {
            for (int rep = 0; rep < NREP(2); ++rep) { LAUNDER();
            pg8::StaticOrder S; S.init(M, D, G, bid);
            if ((pg8::F8_MASK >> step) & 1) {
                pg8::Gemm g{HP, (const bf16*)(WL + (f ? WO_D2 : WO_D1)), M, D, FF / 2, pg8::H_PAD8};
                pg8::EpiResid E{XB, ssqb + (cur ^ 1) * M, (rep + 1 == NREP(2)) ? 1.0f / (pg8::H8_SCALE * pg8::WD8_SCALE) : 0.f, (f == 1 && ((pg8::F8GU_MASK >> (step + 1)) & 1)) ? XB8 : nullptr};
                pg8::gemm_phase<pg8::EpiResid, pg8::StaticOrder, true, true, true>(lds + RING_OFF, g, S, E, ptid);
            } else {
                pg8::Gemm g{HP, (const bf16*)(WL + (f ? WO_D2 : WO_D1)), M, D, FF, pg8::H_PAD16};
                pg8::EpiResid E{XB, ssqb + (cur ^ 1) * M, (rep + 1 == NREP(2)) ? 1.f : 0.f, (f == 1 && ((pg8::F8GU_MASK >> (step + 1)) & 1)) ? XB8 : nullptr};
                pg8::gemm_phase<pg8::EpiResid, pg8::StaticOrder, true, true, false>(lds + RING_OFF, g, S, E, ptid);
            }
        }
        }
        SEAM(ph); ++ph; cur ^= 1;
        if (f == 0) {
            if (EN(3) && IN(ph)) {
            for (int rep = 0; rep < NREP(3); ++rep) { LAUNDER();
                if (ptid < 128) __hip_atomic_store(ssqb + (cur ^ 1) * M + OWN_ROW0(bid) + ptid, (pg8::ssq_t)0, RLX_AGENT);
                pg8::Gemm g{XB, (const bf16*)(WL + WO_IN), M, NPROJ - 256 * TAIL_SPLIT, D}; pg8::StaticOrder S; S.init(M, NPROJ - 256 * TAIL_SPLIT, G, bid);
                pg8::EpiMix E{HP, ssqb + cur * M, args.in[7] + l * 256};
                pg8::gemm_phase<pg8::EpiMix, pg8::StaticOrder, true, true>(lds + RING_OFF, g, S, E, ptid);
            }
        }
            SEAM(ph); ++ph;
            if (EN(4) && IN(ph)) {
            for (int rep = 0; rep < NREP(4); ++rep) { LAUNDER();
              const int x8 = bid & 7, j8 = bid >> 3;
              if (j8 < RET_WGS / 8) {
                constexpr int RK = 0, RV = TILE_BYTES;
                int bidl = j8; asm volatile("" : "+s"(bidl));
                const int b = 2 * x8 + (bidl >> 2), h = bidl & 3;
                const float Gam = pg8::fexp2(128.f * pg8::log2_decay(h));
                {
                f32x4 ST[8];
#pragma unroll
                for (int db = 0; db < 8; ++db) ST[db] = (f32x4){0.f, 0.f, 0.f, 0.f};
                v4u pf[8], pg[8], ph8[8];
#define KV_LOAD(dst_, n_) do { _Pragma("unroll") for (int i = 0; i < 4; ++i) { const int c = ptid + 512 * i, row = c >> 4, ch = c & 15; const bf16* src = HP + pg8::ptile(b * SEQ + (n_) * CHUNK + row, h, 1) + ch * 8; \
                    dst_[i] = *(const GAS v4u*)src; dst_[4 + i] = *(const GAS v4u*)(src + 16384); } } while (0)
                constexpr int NTRIP = (NCH - 1);
                KV_LOAD(pf, 0); KV_LOAD(pg, 1); KV_LOAD(ph8, 2);
#define KV_PUT(buf_, img_) do { _Pragma("unroll") for (int i = 0; i < 4; ++i) { const int c = ptid + 512 * i, row = c >> 4, ch = c & 15; \
                        *(LAS v4u*)(lds + (img_) * 2 * TILE_BYTES + RK + row * TILE_LD + ch * 16) = buf_[i]; *(LAS v4u*)(lds + (img_) * 2 * TILE_BYTES + RV + row * TILE_LD + ch * 16) = buf_[4 + i]; } \
                    asm volatile("" ::: "memory"); } while (0)
                __syncthreads();
                KV_PUT(pf, 0); KV_LOAD(pf, 3);
#define CHAIN_STEP(nbuf_, n_) do { constexpr int n = (n_), img = n & 1; \
                    __syncthreads();                                                 \
                    if (n + 1 < NTRIP) { KV_PUT(nbuf_, img ^ 1); if (n + 4 < NTRIP) KV_LOAD(nbuf_, n + 4); } \
                    const unsigned ib = lds_base + img * 2 * TILE_BYTES; \
                    bf16x8 av[4];                                                    \
                    _Pragma("unroll") for (int ks = 0; ks < 4; ++ks) av[ks] = tr_frag<TILE_LD>(ib + RV + (32 * ks + 8 * q4 + tq) * TILE_LD + (16 * wave + 4 * tp) * 2); \
                    bf16x8 ak[2][8];                                                 \
                    _Pragma("unroll") for (int db = 0; db < 8; ++db) ak[0][db] = tr_frag<TILE_LD>(ib + RK + (8 * q4 + tq) * TILE_LD + (16 * db + 4 * tp) * 2); \
                    _Pragma("unroll") for (int ks = 0; ks < 4; ++ks) { \
                        if (ks < 3) { _Pragma("unroll") for (int db = 0; db < 8; ++db) ak[(ks + 1) & 1][db] = tr_frag<TILE_LD>(ib + RK + (32 * (ks + 1) + 8 * q4 + tq) * TILE_LD + (16 * db + 4 * tp) * 2); } \
                        _Pragma("unroll") for (int db = 0; db < 8; ++db) ST[db] = MFMA16(ak[ks & 1][db], av[ks], ST[db]); \
                        __builtin_amdgcn_sched_barrier(0); } \
                    bf16* pt = PT + (size_t)((b * NCH + n + 1) * 4 + h) * 16384 + (16 * wave + l15) * 128 + 4 * q4; \
                    _Pragma("unroll") for (int db = 0; db < 8; ++db) { ST[db] = ST[db] * Gam; u32x2 o; o.x = pg8::cvt_pk_bf16(ST[db][0], ST[db][1]); o.y = pg8::cvt_pk_bf16(ST[db][2], ST[db][3]); *(GAS u32x2*)(pt + 16 * db) = o; } \
                } while (0)
                static_assert(NTRIP == 15, "the chain is written out step by step");
                CHAIN_STEP(pg, 0); CHAIN_STEP(ph8, 1); CHAIN_STEP(pf, 2); CHAIN_STEP(pg, 3); CHAIN_STEP(ph8, 4); CHAIN_STEP(pf, 5); CHAIN_STEP(pg, 6); CHAIN_STEP(ph8, 7);
                CHAIN_STEP(pf, 8); CHAIN_STEP(pg, 9); CHAIN_STEP(ph8, 10); CHAIN_STEP(pf, 11); CHAIN_STEP(pg, 12); CHAIN_STEP(ph8, 13); CHAIN_STEP(pf, 14);
                __syncthreads(); }
#undef CHAIN_STEP
#undef KV_PUT
#undef KV_LOAD
              } else {
                const int wb = (j8 - RET_WGS / 8) * 8 + x8;
                if (TAIL_SPLIT && wb < TAIL_WGS) {
#pragma unroll 1
                    for (int rep10 = 0; rep10 < NREP(10); ++rep10) { LAUNDER();
                    pg8::Gemm g{XB, (const bf16*)(WL + WO_IN) + (size_t)(NPROJ - 256) * D, M, 256, D}; pg8::StaticOrder S; S.init(M, 256, TAIL_WGS, wb);
                    pg8::EpiSilu E{HP, ssqb + cur * M, 2};
                    pg8::gemm_phase<pg8::EpiSilu, pg8::StaticOrder, true, true>(lds + RING_OFF, g, S, E, ptid);
                    __syncthreads(); }
                }
                const int nsh = wb < TAIL_WGS ? 1 : 2, wsh = 32 * x8 + (wb < TAIL_WGS ? j8 - 8 : 16 + 2 * (j8 - 24));
                if (HELPER_PF && wb >= TAIL_WGS) {
                    const int q = j8 - 24, pb = 2 * x8 + (q >> 2), phd = q & 3;
                    const unsigned kvlo = (unsigned)((ptid >> 4) * 128 + (ptid & 15) * 8);
#pragma unroll 1
                    for (int n = 0; n < NCH - 1; ++n) {
                        const bf16* kvu = HP + pg8::ptile(pb * SEQ + n * CHUNK, phd, 1) + kvlo; v4u t[8];
#pragma unroll
                        for (int i = 0; i < 4; ++i) { t[i] = *(const GAS v4u*)(kvu + i * 4096); t[4 + i] = *(const GAS v4u*)(kvu + i * 4096 + 16384); }
#pragma unroll
                        for (int i = 0; i < 8; ++i) asm volatile("" :: "v"(t[i]));
                    }
                }
                for (int rep6 = 0; rep6 < NREP(6); ++rep6) {
                for (int sh = wsh; sh < wsh + nsh; ++sh) {
                    const int R0 = sh * CHUNK, t = 16 * wave + l15, row = R0 + t;
                    constexpr int UOFF = 2 * TILE_BYTES, UL = 528;
                    v4u pv[4][2]; v4u pu[8]; float bsv[4]; v4u pw[4];
#pragma unroll
                    for (int i = 0; i < 8; ++i) { const int c = ptid + 512 * i; pu[i] = *(const GAS v4u*)(HP + pg8::prow_off(R0 + (c >> 5)) + (c & 31) * 8); }
#pragma unroll
                    for (int gq = 0; gq < 4; ++gq) {
#pragma unroll
                        for (int i = 0; i < 2; ++i) { const int c = ptid + 512 * i; pv[gq][i] = *(const GAS v4u*)(HP + pg8::prow_off(R0 + (c >> 3)) + 256 + 64 * gq + (c & 7) * 8); }
                        bsv[gq] = args.in[9][(l * 4 + gq) * 128 + t];
                    }
#define W_LOAD(gq_) do { _Pragma("unroll") for (int i = 0; i < 4; ++i) { const int c = ptid + 512 * i; pw[i] = *(const GAS v4u*)(WTRIL + (size_t)(l * 4 + (gq_)) * 16384 + (c >> 4) * 128 + (c & 15) * 8); } } while (0)
                    W_LOAD(0);
#pragma unroll
                    for (int gq = 0; gq < 4; ++gq) {
                        __syncthreads();
#pragma unroll
                        for (int i = 0; i < 4; ++i) { const int c = ptid + 512 * i; *(LAS v4u*)(lds + (c >> 4) * TILE_LD + (c & 15) * 16) = pw[i]; }
#pragma unroll
                        for (int i = 0; i < 2; ++i) { const int c = ptid + 512 * i; *(LAS v4u*)(lds + TILE_BYTES + (c >> 3) * 144 + (c & 7) * 16) = pv[gq][i]; }
                        if (gq == 0) {
#pragma unroll
                            for (int i = 0; i < 8; ++i) { const int c = ptid + 512 * i; *(LAS v4u*)(lds + UOFF + (c >> 5) * UL + (c & 31) * 16) = pu[i]; } }
                        asm volatile("" ::: "memory");
                        if (gq + 1 < 4) W_LOAD(gq + 1);
                        __syncthreads();
                        f32x4 acc[4];
#pragma unroll
                        for (int db = 0; db < 4; ++db) acc[db] = (f32x4){0.f, 0.f, 0.f, 0.f};
                        const int kmax = wave >> 1;
#pragma unroll
                        for (int ks = 0; ks < 4; ++ks) if (ks <= kmax) {
                            const bf16x8 bw = *(const LAS bf16x8*)(lds + (16 * wave + l15) * TILE_LD + (32 * ks + 8 * q4) * 2);
#pragma unroll
                            for (int db = 0; db < 4; ++db) { const bf16x8 av = tr_frag<144>(lds_base + TILE_BYTES + (32 * ks + 8 * q4 + tq) * 144 + (16 * db + 4 * tp) * 2); acc[db] = MFMA16(av, bw, acc[db]); }
                        }
#pragma unroll
                        for (int db = 0; db < 4; ++db) { const int col = 64 * gq + 16 * db + 4 * q4; const float bb = bsv[gq];
                            LAS u32x2* up = (LAS u32x2*)(lds + UOFF + t * UL + col * 2); const u32x2 uu = *up;
                            u32x2 o; o.x = pg8::cvt_pk_bf16(bflo(uu.x) * (acc[db][0] + bb), bfhi(uu.x) * (acc[db][1] + bb)); o.y = pg8::cvt_pk_bf16(bflo(uu.y) * (acc[db][2] + bb), bfhi(uu.y) * (acc[db][3] + bb));
                            *up = o; }
                    }
                    __syncthreads();
#pragma unroll
                    for (int i = 0; i < 8; ++i) { const int c = ptid + 512 * i; *(GAS v4u*)(Y + (size_t)(R0 + (c >> 5)) * D + (c & 31) * 8) = *(const LAS v4u*)(lds + UOFF + (c >> 5) * UL + (c & 31) * 16); }
#undef W_LOAD
                }
                __syncthreads();
                for (int sh = wsh; sh < wsh + nsh; ++sh) { const int it = sh * 512 + ptid;
                    const int rb = it >> 5, c8 = (it & 31) * 8, row0 = rb * 8; const float* cw = args.in[10] + l * 768 + c8;
                    float w0[8], w1[8], w2[8], z2[8], z1[8];
#pragma unroll
                    for (int j = 0; j < 8; ++j) { w0[j] = cw[j]; w1[j] = cw[256 + j]; w2[j] = cw[512 + j]; z2[j] = 0.f; z1[j] = 0.f; }
                    if ((row0 & (SEQ - 1)) != 0) {
                        const v4u a = *(const GAS v4u*)(HP + pg8::prow_off(row0 - 2) + 768 + c8), b = *(const GAS v4u*)(HP + pg8::prow_off(row0 - 1) + 768 + c8);
                        z2[0] = bflo(a.x); z2[1] = bfhi(a.x); z2[2] = bflo(a.y); z2[3] = bfhi(a.y); z2[4] = bflo(a.z); z2[5] = bfhi(a.z); z2[6] = bflo(a.w); z2[7] = bfhi(a.w);
                        z1[0] = bflo(b.x); z1[1] = bfhi(b.x); z1[2] = bflo(b.y); z1[3] = bfhi(b.y); z1[4] = bflo(b.z); z1[5] = bfhi(b.z); z1[6] = bflo(b.w); z1[7] = bfhi(b.w);
                    }
                    v4u zcv[8], bgv[8];
#pragma unroll
                    for (int j = 0; j < 8; ++j) { zcv[j] = *(const GAS v4u*)(HP + pg8::prow_off(row0 + j) + 768 + c8); bgv[j] = *(const GAS v4u*)(HP + pg8::prow_off(row0 + j) + 512 + c8); }
#pragma unroll
                    for (int j = 0; j < 8; ++j) {
                        const v4u zc = zcv[j], bg = bgv[j];
                        float z0[8], g8[8], y[8];
                        z0[0] = bflo(zc.x); z0[1] = bfhi(zc.x); z0[2] = bflo(zc.y); z0[3] = bfhi(zc.y); z0[4] = bflo(zc.z); z0[5] = bfhi(zc.z); z0[6] = bflo(zc.w); z0[7] = bfhi(zc.w);
                        g8[0] = bflo(bg.x); g8[1] = bfhi(bg.x); g8[2] = bflo(bg.y); g8[3] = bfhi(bg.y); g8[4] = bflo(bg.z); g8[5] = bfhi(bg.z); g8[6] = bflo(bg.w); g8[7] = bfhi(bg.w);
#pragma unroll
                        for (int k = 0; k < 8; ++k) { y[k] = g8[k] * (w0[k] * z2[k] + w1[k] * z1[k] + w2[k] * z0[k]); z2[k] = z1[k]; z1[k] = z0[k]; }
                        v4u o; o.x = pg8::cvt_pk_bf16(y[0], y[1]); o.y = pg8::cvt_pk_bf16(y[2], y[3]); o.z = pg8::cvt_pk_bf16(y[4], y[5]); o.w = pg8::cvt_pk_bf16(y[6], y[7]);
                        *(GAS v4u*)(Y + (size_t)(row0 + j) * D + 256 + c8) = o;
                    }
                }
                }
              }
            }
        }
            SEAM(ph); ++ph;
            if (EN(5) && IN(ph)) {
            for (int rep = 0; rep < NREP(5); ++rep) { LAUNDER();
                constexpr int RQ = 0, RK = TILE_BYTES, RV = 2 * TILE_BYTES, RS = 3 * TILE_BYTES, RPST = 0, RSTT = 8192;
                v4u pf[12];
#define RET_LOAD(un_) do { const int h_ = (un_) & 3, bn_ = (un_) >> 2; _Pragma("unroll") for (int i = 0; i < 4; ++i) { const int c = ptid + 512 * i, row = c >> 4, ch = c & 15; const bf16* src = HP + pg8::ptile(bn_ * CHUNK + row, h_, 0) + ch * 8; \
                    pf[i] = *(const GAS v4u*)src; pf[4 + i] = *(const GAS v4u*)(src + 16384); pf[8 + i] = *(const GAS v4u*)(src + 2 * 16384); } } while (0)
                const int un0 = 128 * (bid & 7) + (bid >> 3), un1 = 128 * (bid & 7) + 128;
                RET_LOAD(un0);
                v4u pan[4];
#pragma unroll
                for (int ks = 0; ks < 4; ++ks) pan[ks] = *(const GAS v4u*)(PT + (size_t)un0 * 16384 + (16 * wave + l15) * 128 + 32 * ks + 8 * q4);
#pragma unroll 1
                for (int un = un0; un < un1; un += G / 8) {
                    const int h = un & 3, bn = un >> 2, n = bn & (NCH - 1);
                    const int vcol = 128 * h + 16 * wave + 4 * q4;
                    __syncthreads();
#pragma unroll
                    for (int i = 0; i < 4; ++i) { const int c = ptid + 512 * i, row = c >> 4, ch = c & 15;
                        *(LAS v4u*)(lds + RQ + row * TILE_LD + ch * 16) = pf[i]; *(LAS v4u*)(lds + RK + row * TILE_LD + ch * 16) = pf[4 + i]; *(LAS v4u*)(lds + RV + row * TILE_LD + ch * 16) = pf[8 + i]; }
                    asm volatile("" ::: "memory");
                    v4u pgc[4];
#pragma unroll
                    for (int i = 0; i < 4; ++i) { const int c = ptid + 512 * i; pgc[i] = *(const GAS v4u*)(HP + pg8::ptile(bn * CHUNK + (c >> 4), h, 3) + (c & 15) * 8); }
                    v4u pa[4];
#pragma unroll
                    for (int ks = 0; ks < 4; ++ks) pa[ks] = pan[ks];
                    if (un + G / 8 < un1) { RET_LOAD(un + G / 8);
#pragma unroll
                        for (int ks = 0; ks < 4; ++ks) pan[ks] = *(const GAS v4u*)(PT + (size_t)(un + G / 8) * 16384 + (16 * wave + l15) * 128 + 32 * ks + 8 * q4); }
                    __syncthreads();
                    { int idx = 0;
#pragma unroll
                      for (int tb = 0; tb < 8; ++tb) {
#pragma unroll
                        for (int cb = 0; cb <= tb; ++cb) {
                            if ((idx & 7) == wave) {
                                f32x4 sa = (f32x4){0.f, 0.f, 0.f, 0.f};
                                bf16x8 ak[4], bq[4];
#pragma unroll
                                for (int ks = 0; ks < 4; ++ks) { ak[ks] = *(const LAS bf16x8*)(lds + RK + (16 * cb + l15) * TILE_LD + (32 * ks + 8 * q4) * 2); bq[ks] = *(const LAS bf16x8*)(lds + RQ + (16 * tb + l15) * TILE_LD + (32 * ks + 8 * q4) * 2); }
#pragma unroll
                                for (int ks = 0; ks < 4; ++ks) sa = MFMA16(ak[ks], bq[ks], sa);
                                if (cb == tb) {
#pragma unroll
                                    for (int e = 0; e < 4; ++e) if (4 * q4 + e > l15) sa[e] = 0.f; }
                                u32x2 o; o.x = pg8::cvt_pk_bf16(sa[0], sa[1]); o.y = pg8::cvt_pk_bf16(sa[2], sa[3]);
                                *(LAS u32x2*)(lds + RS + (16 * tb + l15) * TILE_LD + (16 * cb + 4 * q4) * 2) = o;
                            }
                            ++idx;
                        }
                        if ((tb & 1) == 0 && wave == 4 + (tb >> 1)) *(LAS u32x2*)(lds + RS + (16 * tb + l15) * TILE_LD + (16 * (tb + 1) + 4 * q4) * 2) = (u32x2){(unsigned)ptid >> 31, (unsigned)ptid >> 31};
                      } }
                    f32x4 RT[8];
#pragma unroll
                    for (int tb = 0; tb < 8; ++tb) RT[tb] = (f32x4){0.f, 0.f, 0.f, 0.f};
                    if (n > 0) {
                        bf16x8 bq[8];
#pragma unroll
                        for (int tb = 0; tb < 8; ++tb) bq[tb] = *(const LAS bf16x8*)(lds + RQ + (16 * tb + l15) * TILE_LD + (8 * q4) * 2);
#pragma unroll
                        for (int ks = 0; ks < 4; ++ks) {
                            const bf16x8 af = __builtin_bit_cast(bf16x8, pa[ks]);
#pragma unroll
                            for (int tb = 0; tb < 8; ++tb) { RT[tb] = MFMA16(af, bq[tb], RT[tb]);
                                if (ks < 3) bq[tb] = *(const LAS bf16x8*)(lds + RQ + (16 * tb + l15) * TILE_LD + (32 * (ks + 1) + 8 * q4) * 2);
                                __builtin_amdgcn_sched_barrier(0); }
                        }
                    }
                    __syncthreads();
#pragma unroll
                    for (int i = 0; i < 4; ++i) { const int c = ptid + 512 * i; *(LAS v4u*)(lds + RK + (c >> 4) * TILE_LD + (c & 15) * 16) = pgc[i]; }
                    bf16x8 av[4];
#pragma unroll
                    for (int ks = 0; ks < 4; ++ks) av[ks] = tr_frag<TILE_LD>(lds_base + RV + (32 * ks + 8 * q4 + tq) * TILE_LD + (16 * wave + 4 * tp) * 2);
                    { bf16x8 bs[6];
#pragma unroll
                      for (int i = 0; i < 6; ++i) bs[i] = *(const LAS bf16x8*)(lds + RS + (16 * inner_tb(i) + l15) * TILE_LD + (32 * inner_ks(i) + 8 * q4) * 2);
#pragma unroll
                      for (int i = 0; i < 20; ++i) { RT[inner_tb(i)] = MFMA16(av[inner_ks(i)], bs[i % 6], RT[inner_tb(i)]);
                          if (i + 6 < 20) bs[i % 6] = *(const LAS bf16x8*)(lds + RS + (16 * inner_tb(i + 6) + l15) * TILE_LD + (32 * inner_ks(i + 6) + 8 * q4) * 2);
                          __builtin_amdgcn_sched_barrier(0); } }
#pragma unroll
                    for (int tb = 0; tb < 8; ++tb) {
                        float p1 = (RT[tb][0] + RT[tb][1]) + (RT[tb][2] + RT[tb][3]), p2 = (RT[tb][0] * RT[tb][0] + RT[tb][1] * RT[tb][1]) + (RT[tb][2] * RT[tb][2] + RT[tb][3] * RT[tb][3]);
                        p1 += __shfl_xor(p1, 16); p1 += __shfl_xor(p1, 32); p2 += __shfl_xor(p2, 16); p2 += __shfl_xor(p2, 32);
                        if (q4 == 0) *(LAS pg8::f32x2*)(lds + RPST + (wave * 128 + 16 * tb + l15) * 8) = (pg8::f32x2){p1, p2};
                    }
                    __syncthreads();
                    if (ptid < 128) {
                        float s1 = 0.f, s2 = 0.f;
#pragma unroll
                        for (int w8 = 0; w8 < 8; ++w8) { const pg8::f32x2 p = *(const LAS pg8::f32x2*)(lds + RPST + (w8 * 128 + ptid) * 8); s1 += p.x; s2 += p.y; }
                        const float mu = s1 * (1.0f / 128.0f), var = fmaxf(s2 * (1.0f / 128.0f) - mu * mu, 0.f);
                        *(LAS pg8::f32x2*)(lds + RSTT + ptid * 8) = (pg8::f32x2){mu, __builtin_amdgcn_rsqf(var + EPS)};
                    }
                    __syncthreads();
                    const f32x4 gv = *(const GAS f32x4*)(args.in[11] + l * 512 + vcol);
#pragma unroll
                    for (int tb = 0; tb < 8; ++tb) {
                        const pg8::f32x2 st = *(const LAS pg8::f32x2*)(lds + RSTT + (16 * tb + l15) * 8);
                        const u32x2 gg = *(const LAS u32x2*)(lds + RK + (16 * tb + l15) * TILE_LD + (16 * wave + 4 * q4) * 2);
                        u32x2 o; o.x = pg8::cvt_pk_bf16((RT[tb][0] - st.x) * st.y * gv[0] * bflo(gg.x), (RT[tb][1] - st.x) * st.y * gv[1] * bfhi(gg.x));
                        o.y = pg8::cvt_pk_bf16((RT[tb][2] - st.x) * st.y * gv[2] * bflo(gg.y), (RT[tb][3] - st.x) * st.y * gv[3] * bfhi(gg.y));
                        *(LAS u32x2*)(lds + RS + (16 * tb + l15) * TILE_LD + (16 * wave + 4 * q4) * 2) = o;
                    }
                    __syncthreads();
#pragma unroll
                    for (int i = 0; i < 4; ++i) { const int c = ptid + 512 * i, row = c >> 4, ch = c & 15;
                        *(GAS v4u*)(Y + (size_t)(bn * CHUNK + row) * D + 512 + 128 * h + ch * 8) = *(const LAS v4u*)(lds + RS + row * TILE_LD + ch * 16); }
                }
#undef RET_LOAD
            }
        }
            SEAM(ph); ++ph;
            if (EN(7) && IN(ph)) {
            for (int rep = 0; rep < NREP(7); ++rep) { LAUNDER();
                pg8::Gemm g{Y, (const bf16*)(WL + WO_OUT), M, D, D}; pg8::StaticOrder S; S.init(M, D, G, bid);
                pg8::EpiResid E{XB, ssqb + (cur ^ 1) * M, (rep + 1 == NREP(7)) ? 1.f : 0.f, ((pg8::F8GU_MASK >> (step + 1)) & 1) ? XB8 : nullptr};
                pg8::gemm_phase<pg8::EpiResid, pg8::StaticOrder, true, true>(lds + RING_OFF, g, S, E, ptid);
            }
        }
            SEAM(ph); ++ph; cur ^= 1;
        }
    }
    if (EN(8) && IN(ph)) {
        LAUNDER();
        const float* fg = args.in[17]; float* out = args.out;
        f32x4 gv[4];
#pragma unroll
        for (int q = 0; q < 4; ++q) gv[q] = *(const GAS f32x4*)(fg + 4 * lane + 256 * q);
        for (int m0 = OWN_ROW0(bid) + 4 * wave; m0 < OWN_ROW0(bid) + M / G; m0 += 4 * NWAVES) {
            u32x2 w[4][4];
#pragma unroll
            for (int r = 0; r < 4; ++r)
#pragma unroll
                for (int q = 0; q < 4; ++q) w[r][q] = *(const GAS u32x2*)(XB + (size_t)(m0 + r) * D + 4 * lane + 256 * q);
#pragma unroll
            for (int r = 0; r < 4; ++r) {
                f32x4 v[4]; float s = 0.f;
#pragma unroll
                for (int q = 0; q < 4; ++q) { v[q] = (f32x4){bflo(w[r][q].x), bfhi(w[r][q].x), bflo(w[r][q].y), bfhi(w[r][q].y)}; s += (v[q].x * v[q].x + v[q].y * v[q].y) + (v[q].z * v[q].z + v[q].w * v[q].w); }
                const float rstd = __builtin_amdgcn_rsqf(wave_sum(s) * (1.0f / D) + EPS);
#pragma unroll
                for (int q = 0; q < 4; ++q) *(GAS f32x4*)(out + (size_t)(m0 + r) * D + 4 * lane + 256 * q) = v[q] * rstd * gv[q];
            }
        }
    }
#undef WL
#undef IN
#undef SEAM
}

extern "C" void kernel_launch(void* const* d_in, const int* in_sizes, int n_in, void* d_out, int out_size, void* d_ws, size_t ws_size, hipStream_t stream) {
    static int grid = 0;
    if (grid == 0) {
        if (n_in != 18 || in_sizes[0] != M * D || out_size != M * D || ws_size < WS_END) { fprintf(stderr, "kernel_launch: shape/workspace mismatch (n_in %d, in0 %d, out %d, ws %zu); nothing launched\n", n_in, n_in > 0 ? in_sizes[0] : -1, out_size, ws_size); grid = -1; return; }
        int dev = 0, cus = 0, per_cu = 0;
        if (hipGetDevice(&dev) != hipSuccess || hipDeviceGetAttribute(&cus, hipDeviceAttributeMultiprocessorCount, dev) != hipSuccess) { grid = -1; return; }
        if (hipFuncSetAttribute((const void*)fwd_kernel, hipFuncAttributeMaxDynamicSharedMemorySize, LDS_BYTES) != hipSuccess) { fprintf(stderr, "kernel_launch: hipFuncSetAttribute failed\n"); grid = -1; return; }
        if (hipOccupancyMaxActiveBlocksPerMultiprocessor(&per_cu, (const void*)fwd_kernel, NWAVES * 64, LDS_BYTES) != hipSuccess || per_cu < 1)
            fprintf(stderr, "kernel_launch: note: occupancy query reports %d workgroups per CU\n", per_cu);
        (void)hipGetLastError();
        grid = cus;
    }
    if (grid < 0) return;
    if (hipMemsetAsync((char*)d_ws + WS_CTL, 0, CTL_ZERO_BYTES, stream) != hipSuccess) return;
    Args a{};
    for (int i = 0; i < 18; ++i) a.in[i] = (const float*)d_in[i];
    a.out = (float*)d_out; a.ws = (unsigned char*)d_ws;
    for (int li = 0; li < N_LAUNCHES; ++li) {
        a.ph_lo = (N_LAUNCHES == 1) ? 0 : li; a.ph_hi = (N_LAUNCHES == 1) ? N_PHASES : li + 1; a.li = li; a.pad = 0;
        hipLaunchKernelGGL(fwd_kernel, dim3(grid), dim3(NWAVES * 64), LDS_BYTES, stream, a);
        const hipError_t le = hipPeekAtLastError();
        if (le != hipSuccess) { fprintf(stderr, "kernel_launch: launch %d failed: %s\n", li, hipGetErrorName(le)); break; }
    }
}
```

```cpp
#include <hip/hip_runtime.h>
#include <cstdio>
#include <cstdint>
namespace pg8 {
#define PG8_LAS __attribute__((address_space(3)))
typedef unsigned short bf16_t;
typedef short bf16x8 __attribute__((ext_vector_type(8)));
typedef float f32x4 __attribute__((ext_vector_type(4)));
typedef unsigned u32x4 __attribute__((ext_vector_type(4)));
typedef int i32x4 __attribute__((ext_vector_type(4)));
typedef int i32x8 __attribute__((ext_vector_type(8)));
constexpr int BM = 256, BK = 64, HALF = 128, HTB = HALF * BK * 2  , STAGE_BYTES = 8 * HTB, NXCD = 8, WGM = 8;

__host__ __device__ __forceinline__ int lds_byte(int r, int c) { const int st = (r >> 4) * 2 + (c >> 5), rr = r & 15, cc = c & 31, ob = rr * 64 + cc * 2; return st * 1024 + (ob ^ (((ob >> 9) & 1) << 5)); }
__host__ __device__ __forceinline__ void stage_rc(int b, int& R, int& C) { const int st = b / 1024, sb = b % 1024, swz = sb ^ (((sb >> 9) & 1) << 5); R = (st >> 1) * 16 + swz / 64; C = (st & 1) * 32 + (swz % 64) / 2; }
__host__ __device__ __forceinline__ int perm32(int rho) { const int n = rho >> 4, i = rho & 15; return 8 * (i >> 2) + 4 * n + (i & 3); }

struct Unit { int pm, pn; };
struct Gemm { const bf16_t* A; const bf16_t* Bt; int M, N, K; unsigned a_pad = 0; };

struct StaticOrder {
    int nM, nN, nwg, G, c;
    __host__ __device__ void init(int M, int N, int G_, int c_) { nM = M / BM; nN = N / BM; nwg = nM * nN; G = G_; c = c_; }
    __host__ __device__ bool next(int i, Unit& u) const {
        const long L = (long)i * G + c; if (L >= nwg) return false;
        int wgid = (int)L; { const int q = nwg / NXCD, r = nwg % NXCD, xcd = wgid % NXCD, off = wgid / NXCD; wgid = (xcd < r ? xcd * (q + 1) : r * (q + 1) + (xcd - r) * q) + off; }
        const int nig = WGM * nN, gid = wgid / nig, fm = gid * WGM, gsz = (nM % WGM == 0) ? WGM : ((nM - fm) < WGM ? (nM - fm) : WGM);
        u.pm = fm + ((wgid % nig) % gsz); u.pn = (wgid % nig) / gsz; return true;
    }
    __device__ __forceinline__ void a_ready(const Unit&) const {}
    __device__ __forceinline__ void done(const Unit&) const {}
};
struct RoundOrder : StaticOrder {
    int i0;
    __host__ __device__ bool next(int i, Unit& u) const { return i == 0 ? StaticOrder::next(i0, u) : false; }
};

typedef float f32x2_cv __attribute__((ext_vector_type(2))); typedef __bf16 bf16x2_cv __attribute__((ext_vector_type(2)));
__device__ __forceinline__ unsigned cvt_pk_bf16(float lo, float hi) { const f32x2_cv v = {lo, hi}; const bf16x2_cv b = __builtin_convertvector(v, bf16x2_cv); return __builtin_bit_cast(unsigned, b); }
typedef float f32x2 __attribute__((ext_vector_type(2)));
typedef float f32x2 __attribute__((ext_vector_type(2)));
__device__ __forceinline__ float fexp2(float x) { return __builtin_amdgcn_exp2f(x); }
__device__ __forceinline__ float frcp(float x) { return __builtin_amdgcn_rcpf(x); }
__device__ __forceinline__ float silu_f(float x) { return x * frcp(1.f + fexp2(-1.4426950408889634f * x)); }
__device__ __forceinline__ float gelu_f(float x) { const float u = x * (1.f + 0.044715f * x * x) * 2.302208198144325f; return x * frcp(1.f + fexp2(-u)); }
__device__ __forceinline__ f32x4 sigm4(f32x4 t) {
#pragma unroll
    for (int e = 0; e < 4; ++e) t[e] = fexp2(t[e]);
    t = t + 1.f;
#pragma unroll
    for (int e = 0; e < 4; ++e) t[e] = frcp(t[e]);
    return t; }
__device__ __forceinline__ f32x4 silu4(const f32x4 x) { return x * sigm4(x * -1.4426950408889634f); }
__device__ __forceinline__ f32x4 gelu4(const f32x4 x) { return x * sigm4((x * (x * x * 0.044715f + 1.f)) * -2.302208198144325f); }
__device__ __forceinline__ float log2_decay(int h) { const float x = __builtin_bit_cast(float, (unsigned)(122 - h) << 23); return -1.4426950408889634f * (x * (1.f + x * (0.5f + x * (0.3333333433f + x * (0.25f + x * 0.2f))))); }
__device__ __forceinline__ float ld_sc1(const float* p) { return __hip_atomic_load(p, __ATOMIC_RELAXED, __HIP_MEMORY_SCOPE_AGENT); }
typedef unsigned int ssq_t;
constexpr float SSQ_FIX = 4096.0f, SSQ_INV = 1.0f / 4096.0f;
__device__ __forceinline__ ssq_t ssq_fix(float s) { return (ssq_t)(s * SSQ_FIX); }
__device__ __forceinline__ float row_rstd(const ssq_t* ssq, int r) { const ssq_t v = __hip_atomic_load(ssq + r, __ATOMIC_RELAXED, __HIP_MEMORY_SCOPE_AGENT); return __builtin_amdgcn_rsqf((float)v * (SSQ_INV / 1024.0f) + 1e-6f); }
__device__ __forceinline__ u32x4 pack8(const f32x4& a, const f32x4& b) { u32x4 w; w.x = cvt_pk_bf16(a[0], a[1]); w.y = cvt_pk_bf16(a[2], a[3]); w.z = cvt_pk_bf16(b[0], b[1]); w.w = cvt_pk_bf16(b[2], b[3]); return w; }

struct PreSsq { ssq_t v[2][4]; };
struct PreNone { };
__device__ __forceinline__ void pre_ssq(PreSsq& p, const ssq_t* ssq, int row0) {
#pragma unroll
    for (int ai = 0; ai < 2; ++ai)
#pragma unroll
        for (int m = 0; m < 4; ++m) p.v[ai][m] = __hip_atomic_load(ssq + row0 + ai * 128 + m * 16, __ATOMIC_RELAXED, __HIP_MEMORY_SCOPE_AGENT);
}
__device__ __forceinline__ float rstd_of(ssq_t v) { return __builtin_amdgcn_rsqf((float)v * (SSQ_INV / 1024.0f) + 1e-6f); }
constexpr int DFF = 2816, DM = 1024, PW = 1024;
constexpr size_t SLAB_BYTES = (size_t)24 << 20, SLAB_E = SLAB_BYTES / 2;
constexpr unsigned H_PAD16 = (unsigned)(SLAB_BYTES - (size_t)4096 * DFF * 2), H_PAD8 = (unsigned)(SLAB_BYTES - (size_t)4096 * DFF);
__host__ __device__ __forceinline__ constexpr size_t hrow16(int r) { return (size_t)(r >> 12) * SLAB_E + (size_t)(r & 4095) * DFF; }
__host__ __device__ __forceinline__ constexpr size_t hrow8m(int r) { return (size_t)(r >> 12) * SLAB_BYTES + ((size_t)12 << 20) + (size_t)((r & 4095) - 2048) * DFF; }
constexpr size_t H8M_A_OFF = ((size_t)12 << 20) - (size_t)8 * 256 * DFF;
__host__ __device__ __forceinline__ constexpr size_t hrow8(int r) { return (size_t)(r >> 12) * SLAB_BYTES + (size_t)(r & 4095) * DFF; }
__host__ __device__ __forceinline__ constexpr size_t prow_off(int r) { return (size_t)(r >> 12) * SLAB_E + (size_t)(r & 4095) * PW; }
__host__ __device__ __forceinline__ constexpr size_t ptile(int r, int hd, int t) { return (size_t)(r >> 12) * SLAB_E + (size_t)4096 * PW + ((size_t)((((r >> 7) & 31) * 4 + hd) * 4 + t) << 14) + (size_t)(r & 127) * 128; }
constexpr int F8_MASK = 0xC;
constexpr float H8_SCALE = 8.0f, WD8_SCALE = 256.0f, X8_SCALE = 16.0f, WG8_SCALE = 256.0f;
constexpr int F8H_MASK = 0x2;
constexpr int F8GU_MASK = 0x8;

struct EpiSwiglu {
    static constexpr bool PERM = true, AFTER_DRAIN = false;
    bf16_t* H; const ssq_t* ssq; int skip; int f8; float ascale;
    typedef PreSsq Pre;
    __device__ __forceinline__ void prefetch(Pre& p, const Unit& u, int wr, int fr) const { pre_ssq(p, ssq, u.pm * BM + wr * 64 + fr); }
    __device__ __forceinline__ void operator()(const f32x4 (&acc)[2][2][4][2], const Unit& u, int wr, int wc, int fr, int fq, const Pre& pre) const {
        if (skip) { asm volatile("" :: "v"(acc[0][0][0][0]), "v"(acc[1][1][3][1])); return; }
        const int row0 = u.pm * BM + wr * 64 + fr, col0 = u.pn * 128 + wc * 32 + 8 * fq;
        const int f8u = f8 == 2 ? ((u.pm / WGM) & 1) : f8;
        float rs[2][4];
#pragma unroll
        for (int ai = 0; ai < 2; ++ai)
#pragma unroll
            for (int m = 0; m < 4; ++m) rs[ai][m] = rstd_of(pre.v[ai][m]) * ascale;
#pragma unroll
        for (int ai = 0; ai < 2; ++ai)
#pragma unroll
            for (int m = 0; m < 4; ++m) {
                const float s = rs[ai][m], c = -1.4426950408889634f * s, q = f8u ? s * s * H8_SCALE : s * s; f32x4 h0, h1;
                {
                    const f32x4 g0 = acc[ai][0][m][0], g1 = acc[ai][0][m][1]; f32x4 t0 = g0 * c, t1 = g1 * c;
#pragma unroll
                    for (int e = 0; e < 4; ++e) { t0[e] = fexp2(t0[e]); t1[e] = fexp2(t1[e]); }
                    t0 = t0 + 1.f; t1 = t1 + 1.f;
#pragma unroll
                    for (int e = 0; e < 4; ++e) { t0[e] = frcp(t0[e]); t1[e] = frcp(t1[e]); }
                    h0 = (g0 * acc[ai][1][m][0]) * (t0 * q); h1 = (g1 * acc[ai][1][m][1]) * (t1 * q); }
                if (f8u) {
#pragma unroll
                    for (int e = 0; e < 4; ++e) { h0[e] = __builtin_fminf(__builtin_fmaxf(h0[e], -448.f), 448.f); h1[e] = __builtin_fminf(__builtin_fmaxf(h1[e], -448.f), 448.f); }
                    int w0 = 0, w1 = 0;
                    w0 = __builtin_amdgcn_cvt_pk_fp8_f32(h0[0], h0[1], w0, false); w0 = __builtin_amdgcn_cvt_pk_fp8_f32(h0[2], h0[3], w0, true);
                    w1 = __builtin_amdgcn_cvt_pk_fp8_f32(h1[0], h1[1], w1, false); w1 = __builtin_amdgcn_cvt_pk_fp8_f32(h1[2], h1[3], w1, true);
                    typedef int i32x2 __attribute__((ext_vector_type(2)));
                    *(i32x2*)((unsigned char*)H + (f8 == 2 ? hrow8m(row0 + ai * HALF + m * 16) : hrow8(row0 + ai * HALF + m * 16)) + col0) = (i32x2){w0, w1};
                } else
                *(u32x4*)(H + hrow16(row0 + ai * HALF + m * 16) + col0) = pack8(h0, h1);
            }
    }
};

__device__ __forceinline__ f32x4 unpk_lo(const u32x4& w) { f32x4 r; r[0] = __builtin_bit_cast(float, w.x << 16); r[1] = __builtin_bit_cast(float, w.x & 0xffff0000u); r[2] = __builtin_bit_cast(float, w.y << 16); r[3] = __builtin_bit_cast(float, w.y & 0xffff0000u); return r; }
__device__ __forceinline__ f32x4 unpk_hi(const u32x4& w) { f32x4 r; r[0] = __builtin_bit_cast(float, w.z << 16); r[1] = __builtin_bit_cast(float, w.z & 0xffff0000u); r[2] = __builtin_bit_cast(float, w.w << 16); r[3] = __builtin_bit_cast(float, w.w & 0xffff0000u); return r; }
struct EpiResid {
    static constexpr bool PERM = true, AFTER_DRAIN = false;
    bf16_t* XB; ssq_t* ssq_out; float scale; unsigned char* X8;
    typedef PreNone Pre;
    __device__ __forceinline__ void prefetch(Pre&, const Unit&, int, int) const {}
    __device__ __forceinline__ void operator()(const f32x4 (&acc)[2][2][4][2], const Unit& u, int wr, int wc, int fr, int fq, const Pre&) const {
        const int row0 = u.pm * BM + wr * 64 + fr, col0 = u.pn * BM + wc * 32 + 8 * fq;
        u32x4 base[2][4][2];
#pragma unroll
        for (int ai = 0; ai < 2; ++ai)
#pragma unroll
            for (int m = 0; m < 4; ++m)
#pragma unroll
                for (int bj = 0; bj < 2; ++bj) base[ai][m][bj] = *(const u32x4*)(XB + (size_t)(row0 + ai * HALF + m * 16) * DM + col0 + bj * HALF);
#pragma unroll
        for (int ai = 0; ai < 2; ++ai)
#pragma unroll
            for (int m = 0; m < 4; ++m) {
                const int r = row0 + ai * HALF + m * 16; const size_t off = (size_t)r * DM + col0; float s = 0.f;
#pragma unroll
                for (int bj = 0; bj < 2; ++bj) {
                    const f32x4 x0 = unpk_lo(base[ai][m][bj]) + acc[ai][bj][m][0] * scale, x1 = unpk_hi(base[ai][m][bj]) + acc[ai][bj][m][1] * scale;
                    *(u32x4*)(XB + off + bj * HALF) = pack8(x0, x1);
                    if (X8) { int w0 = 0, w1 = 0;
                        w0 = __builtin_amdgcn_cvt_pk_fp8_f32(__builtin_fminf(__builtin_fmaxf(x0[0] * X8_SCALE, -448.f), 448.f), __builtin_fminf(__builtin_fmaxf(x0[1] * X8_SCALE, -448.f), 448.f), w0, false);
                        w0 = __builtin_amdgcn_cvt_pk_fp8_f32(__builtin_fminf(__builtin_fmaxf(x0[2] * X8_SCALE, -448.f), 448.f), __builtin_fminf(__builtin_fmaxf(x0[3] * X8_SCALE, -448.f), 448.f), w0, true);
                        w1 = __builtin_amdgcn_cvt_pk_fp8_f32(__builtin_fminf(__builtin_fmaxf(x1[0] * X8_SCALE, -448.f), 448.f), __builtin_fminf(__builtin_fmaxf(x1[1] * X8_SCALE, -448.f), 448.f), w1, false);
                        w1 = __builtin_amdgcn_cvt_pk_fp8_f32(__builtin_fminf(__builtin_fmaxf(x1[2] * X8_SCALE, -448.f), 448.f), __builtin_fminf(__builtin_fmaxf(x1[3] * X8_SCALE, -448.f), 448.f), w1, true);
                        typedef int i32x2 __attribute__((ext_vector_type(2)));
                        *(i32x2*)(X8 + off + bj * HALF) = (i32x2){w0, w1}; }
                    { const f32x4 sq = x0 * x0 + x1 * x1; s += (sq[0] + sq[1]) + (sq[2] + sq[3]); }
                }
                s += __shfl_xor(s, 16); s += __shfl_xor(s, 32);
                if (fq == 0) atomicAdd(ssq_out + r, ssq_fix(scale != 0.f ? s : 0.f));
            }
    }
};

struct EpiMix {
    static constexpr bool PERM = true, AFTER_DRAIN = false;
    bf16_t* P; const ssq_t* ssq; const float* vnorm;
    typedef PreSsq Pre;
    __device__ __forceinline__ void prefetch(Pre& p, const Unit& u, int wr, int fr) const { pre_ssq(p, ssq, u.pm * BM + wr * 64 + fr); }
    __device__ __forceinline__ void operator()(const f32x4 (&acc)[2][2][4][2], const Unit& u, int wr, int wc, int fr, int fq, const Pre& pre) const {
        const int pn = u.pn, row0 = u.pm * BM + wr * 64 + fr, cc = wc * 32 + 8 * fq;
        float rs[2][4];
#pragma unroll
        for (int ai = 0; ai < 2; ++ai)
#pragma unroll
            for (int m = 0; m < 4; ++m) rs[ai][m] = rstd_of(pre.v[ai][m]);
#define MIX_ROWS(...) _Pragma("unroll") for (int ai = 0; ai < 2; ++ai) _Pragma("unroll") for (int m = 0; m < 4; ++m) { const int r = row0 + ai * HALF + m * 16; const float s = rs[ai][m]; \
            f32x4 a0 = acc[ai][0][m][0] * s, a1 = acc[ai][0][m][1] * s, b0 = acc[ai][1][m][0] * s, b1 = acc[ai][1][m][1] * s; bf16_t* prow = P + prow_off(r); __VA_ARGS__ asm volatile("" ::: "memory"); }
        if (pn == 2) {
            MIX_ROWS( *(u32x4*)(prow + 512 + cc) = pack8(a0, a1); *(u32x4*)(prow + 512 + cc + 128) = pack8(b0, b1); )
        } else if (pn == 9 || pn == 10) {
            const int hd = 2 * (pn - 9);
            MIX_ROWS( *(u32x4*)(P + ptile(r, hd, 2) + cc) = pack8(a0, a1); *(u32x4*)(P + ptile(r, hd + 1, 2) + cc) = pack8(b0, b1); )
        } else if (pn == 0) {
            MIX_ROWS( a0 = gelu4(a0); a1 = gelu4(a1); b0 = gelu4(b0); b1 = gelu4(b1);
                      *(u32x4*)(prow + cc) = pack8(a0, a1); *(u32x4*)(prow + cc + 128) = pack8(b0, b1); )
        } else if (pn == 11 || pn == 12) {
            const int hd = 2 * (pn - 11);
            MIX_ROWS( a0 = silu4(a0); a1 = silu4(a1); b0 = silu4(b0); b1 = silu4(b1);
                      *(u32x4*)(P + ptile(r, hd, 3) + cc) = pack8(a0, a1); *(u32x4*)(P + ptile(r, hd + 1, 3) + cc) = pack8(b0, b1); )
        } else if (pn == 1) {
            const int ch0 = 64 * wc + 8 * fq;
            const f32x4 g0 = *(const f32x4*)(vnorm + ch0), g1 = *(const f32x4*)(vnorm + ch0 + 4), g2 = *(const f32x4*)(vnorm + ch0 + 32), g3 = *(const f32x4*)(vnorm + ch0 + 36);
            MIX_ROWS( float s1 = 0.f;
                      a0 = gelu4(a0); a1 = gelu4(a1); b0 = gelu4(b0); b1 = gelu4(b1); { const f32x4 sv = (a0 + a1) + (b0 + b1); s1 = (sv[0] + sv[1]) + (sv[2] + sv[3]); }
                      s1 += __shfl_xor(s1, 16); s1 += __shfl_xor(s1, 32); const float mu = s1 * (1.0f / 64.0f); float s2 = 0.f;
                      a0 = a0 - mu; a1 = a1 - mu; b0 = b0 - mu; b1 = b1 - mu;
                      { const f32x4 qv = (a0 * a0 + a1 * a1) + (b0 * b0 + b1 * b1); s2 = (qv[0] + qv[1]) + (qv[2] + qv[3]); }
                      s2 += __shfl_xor(s2, 16); s2 += __shfl_xor(s2, 32); const float rv = __builtin_amdgcn_rsqf(s2 * (1.0f / 64.0f) + 1e-6f);
                      a0 = a0 * rv * g0; a1 = a1 * rv * g1; b0 = b0 * rv * g2; b1 = b1 * rv * g3;
                      *(u32x4*)(prow + 256 + ch0) = pack8(a0, a1); *(u32x4*)(prow + 256 + ch0 + 32) = pack8(b0, b1); )
        } else if (pn == 3 || pn == 4) {
            const int dst = 768 + 128 * (pn - 3) + cc;
            MIX_ROWS( a0 = a0 * b0; a1 = a1 * b1; *(u32x4*)(prow + dst) = pack8(a0, a1); )
        } else {
            const bool isk = pn >= 7; const int hd = 2 * ((pn - 5) & 1) + (wc >> 1), i0 = 32 * (wc & 1) + 8 * fq;
            const float lg = log2_decay(hd);
            const float lgs = isk ? -lg : lg; const int tq = isk ? 1 : 0;
            int rl = row0; asm volatile("" : "+v"(rl));
            float fi[8];
#pragma unroll
            for (int j = 0; j < 8; ++j) fi[j] = fexp2((float)((rl - row0) + i0 + j) * (-13.287712379549449f / 64.0f)) * 0.15915494309189535f;
            MIX_ROWS( const int rr = rl + ai * HALF + m * 16; const float fp = (float)(rr & 2047); const float sc = fexp2((float)(rr & 127) * lgs);
                      f32x4 c0, c1, s0, s1;
                      _Pragma("unroll") for (int e = 0; e < 4; ++e) { const float t0 = __builtin_amdgcn_fractf(fp * fi[e]), t1 = __builtin_amdgcn_fractf(fp * fi[4 + e]);
                          c0[e] = __builtin_amdgcn_cosf(t0); s0[e] = __builtin_amdgcn_sinf(t0); c1[e] = __builtin_amdgcn_cosf(t1); s1[e] = __builtin_amdgcn_sinf(t1); }
                      c0 = c0 * sc; s0 = s0 * sc; c1 = c1 * sc; s1 = s1 * sc;
                      const f32x4 o0 = a0 * c0 - b0 * s0, o1 = a1 * c1 - b1 * s1, p0 = b0 * c0 + a0 * s0, p1 = b1 * c1 + a1 * s1;
                      bf16_t* pq = P + ptile(r, hd, tq) + i0; *(u32x4*)pq = pack8(o0, o1); *(u32x4*)(pq + 64) = pack8(p0, p1); )
        }
#undef MIX_ROWS
    }
};

struct EpiSilu {
    static constexpr bool PERM = true, AFTER_DRAIN = false;
    bf16_t* P; const ssq_t* ssq; int dst0;
    typedef PreSsq Pre;
    __device__ __forceinline__ void prefetch(Pre& p, const Unit& u, int wr, int fr) const { pre_ssq(p, ssq, u.pm * BM + wr * 64 + fr); }
    __device__ __forceinline__ void operator()(const f32x4 (&acc)[2][2][4][2], const Unit& u, int wr, int wc, int fr, int fq, const Pre& pre) const {
        const int row0 = u.pm * BM + wr * 64 + fr, cc = wc * 32 + 8 * fq;
        float rs[2][4];
#pragma unroll
        for (int ai = 0; ai < 2; ++ai)
#pragma unroll
            for (int m = 0; m < 4; ++m) rs[ai][m] = rstd_of(pre.v[ai][m]);
#pragma unroll
        for (int ai = 0; ai < 2; ++ai)
#pragma unroll
            for (int m = 0; m < 4; ++m) { const float s = rs[ai][m]; const int r = row0 + ai * HALF + m * 16;
#pragma unroll
                for (int bj = 0; bj < 2; ++bj) { f32x4 a0 = acc[ai][bj][m][0] * s, a1 = acc[ai][bj][m][1] * s;
                    a0 = silu4(a0); a1 = silu4(a1);
                    *(u32x4*)(P + ptile(r, dst0 + bj, 3) + cc) = pack8(a0, a1); } }
    }
};

#ifndef F8_DEBUG32
#define F8_DEBUG32 0
#endif
template <class Epi, class Sched, bool ALIGN_EPI = false, bool SP2 = false, bool F8 = false  >
__device__ __forceinline__ void gemm_phase(PG8_LAS unsigned char* lds, const Gemm g, const Sched& S, const Epi& E, const int tid  ) {
    const int wid = __builtin_amdgcn_readfirstlane(tid >> 6), lane = tid & 63, wr = wid >> 2, wc = wid & 3, fr = lane & 15, fq = lane >> 4;
    const int K = g.K, nt = K / BK;
    unsigned voffA[2], voffB[2];
#pragma unroll
    for (int i = 0; i < 2; ++i) { int R, C; stage_rc(tid * 16 + i * 8192, R, C); const int Rb = Epi::PERM ? ((R & ~31) + perm32(R & 31)) : R;
        voffA[i] = (unsigned)(R * K + C) * 2u; voffB[i] = (unsigned)(Rb * K + C) * 2u; }
    const size_t kstep = (size_t)(BK * 2);
    const size_t hstep = (size_t)HALF * K * 2;
    const size_t tstep = 2 * hstep;
    const unsigned ldsw = (unsigned)wid * 1024u;
    const int aoff = lds_byte(wr * 64 + fr, fq * 8), boff = lds_byte(wc * 32 + fr, fq * 8);
#define PG8_SA(b, h) (((b) * 2 + (h)) * HTB)
#define PG8_SB(b, h) ((4 + (b) * 2 + (h)) * HTB)
#define PG8_STAGE(bufoff, gbase, voff) do { _Pragma("unroll") for (int _i = 0; _i < 2; ++_i) \
        __builtin_amdgcn_global_load_lds((const unsigned*)((const char*)(gbase) + (voff)[_i]), (PG8_LAS unsigned*)(lds + (bufoff) + ldsw + _i * 8192), 16, 0, 0); } while (0)
#define PG8_LDA(dst, b, h) do { _Pragma("unroll") for (int m = 0; m < 4; ++m) _Pragma("unroll") for (int k = 0; k < 2; ++k) dst[m][k] = *(const PG8_LAS bf16x8*)(lds + PG8_SA(b, h) + aoff + m * 2048 + k * 1024); } while (0)
#define PG8_LDB(dst, b, h) do { _Pragma("unroll") for (int n = 0; n < 2; ++n) _Pragma("unroll") for (int k = 0; k < 2; ++k) dst[n][k] = *(const PG8_LAS bf16x8*)(lds + PG8_SB(b, h) + boff + n * 2048 + k * 1024); } while (0)
#define PG8_MMA(ai, bj, At, Bt) do { __builtin_amdgcn_s_setprio(1); if constexpr (F8) { _Pragma("unroll") for (int m = 0; m < 4; ++m) _Pragma("unroll") for (int n = 0; n < 2; ++n) { \
        const i32x8 b8_ = __builtin_shufflevector(__builtin_bit_cast(i32x4, Bt[n][0]), __builtin_bit_cast(i32x4, Bt[n][1]), 0, 1, 2, 3, 4, 5, 6, 7), a8_ = __builtin_shufflevector(__builtin_bit_cast(i32x4, At[m][0]), __builtin_bit_cast(i32x4, At[m][1]), 0, 1, 2, 3, 4, 5, 6, 7); \
        if (F8_DEBUG32) { typedef long i64x4 __attribute__((ext_vector_type(4))); const i64x4 bl = __builtin_bit_cast(i64x4, b8_), al = __builtin_bit_cast(i64x4, a8_); \
            _Pragma("unroll") for (int q = 0; q < 4; ++q) acc[ai][bj][m][n] = __builtin_amdgcn_mfma_f32_16x16x32_fp8_fp8(bl[q], al[q], acc[ai][bj][m][n], 0, 0, 0); } \
        else asm volatile("v_mfma_scale_f32_16x16x128_f8f6f4 %0, %1, %2, %0, %3, %3 op_sel_hi:[0,0,0]" : "+v"(acc[ai][bj][m][n]) : "v"(b8_), "v"(a8_), "v"(f8scale)); } }     \
      else { _Pragma("unroll") for (int m = 0; m < 4; ++m) _Pragma("unroll") for (int n = 0; n < 2; ++n) _Pragma("unroll") for (int k = 0; k < 2; ++k) \
        acc[ai][bj][m][n] = __builtin_amdgcn_mfma_f32_16x16x32_bf16(Bt[n][k], At[m][k], acc[ai][bj][m][n], 0, 0, 0); } __builtin_amdgcn_s_setprio(0); } while (0)
#define PG8_WAIT_V(n) asm volatile("s_waitcnt vmcnt(" #n ")" ::: "memory")
#define PG8_WAIT_L(n) asm volatile("s_waitcnt lgkmcnt(" #n ")" ::: "memory")
#define PG8_BAR __builtin_amdgcn_s_barrier()
#define PG8_SCHED __builtin_amdgcn_sched_barrier(0)
    Unit cur, nxt; int ui = 0;
    if (!S.next(0, cur)) return;
    f32x4 acc[2][2][4][2];
    int f8scale = 0x7f7f7f7f; if constexpr (F8) asm volatile("" : "+v"(f8scale));
    typename Epi::Pre pre;
#pragma unroll
    for (int a = 0; a < 2; ++a)
#pragma unroll
        for (int b = 0; b < 2; ++b)
#pragma unroll
            for (int m = 0; m < 4; ++m)
#pragma unroll
                for (int n = 0; n < 2; ++n) acc[a][b][m][n] = (f32x4){0.f, 0.f, 0.f, 0.f};
    bf16x8 At[4][2], B0[2][2], B1[2][2];
    const char* cA = (const char*)g.A + (size_t)cur.pm * tstep + (size_t)(cur.pm >> 4) * g.a_pad; const char* cB = (const char*)g.Bt + (size_t)cur.pn * tstep;
    S.a_ready(cur);
    if constexpr (SP2) {
        PG8_STAGE(PG8_SB(0, 0), cB, voffB); PG8_STAGE(PG8_SB(0, 1), cB + hstep, voffB); PG8_STAGE(PG8_SA(0, 0), cA, voffA); PG8_STAGE(PG8_SA(0, 1), cA + hstep, voffA);
        PG8_STAGE(PG8_SB(1, 0), cB + kstep, voffB); PG8_STAGE(PG8_SA(1, 0), cA + kstep, voffA); PG8_STAGE(PG8_SB(1, 1), cB + hstep + kstep, voffB);
        if (wr == 1) PG8_BAR;
        PG8_WAIT_V(8); PG8_BAR;
        PG8_WAIT_V(6); PG8_BAR;
    } else {
        PG8_STAGE(PG8_SB(0, 0), cB, voffB); PG8_STAGE(PG8_SA(0, 0), cA, voffA); PG8_STAGE(PG8_SB(0, 1), cB + hstep, voffB); PG8_STAGE(PG8_SA(0, 1), cA + hstep, voffA);
        if (wr == 1) PG8_BAR;
        PG8_WAIT_V(4); PG8_BAR;
        PG8_STAGE(PG8_SB(1, 0), cB + kstep, voffB); PG8_STAGE(PG8_SA(1, 0), cA + kstep, voffA); PG8_STAGE(PG8_SB(1, 1), cB + hstep + kstep, voffB);
        PG8_WAIT_V(6); PG8_BAR;
    }
    for (;;) {
        const bool has_next = S.next(ui + 1, nxt);
        const char* nA = has_next ? (const char*)g.A + (size_t)nxt.pm * tstep + (size_t)(nxt.pm >> 4) * g.a_pad : cA; const char* nB = has_next ? (const char*)g.Bt + (size_t)nxt.pn * tstep : cB;
        for (int t = 0; t < nt; t += 2) {
            const bool last = (t == nt - 2);
            const char* a1 = cA + (size_t)(t + 1) * kstep;
            const char* a2 = last ? nA : cA + (size_t)(t + 2) * kstep; const char* b2 = last ? nB : cB + (size_t)(t + 2) * kstep;
            const char* a3 = a2 + kstep; const char* b3 = b2 + kstep;
            if (last && has_next) S.a_ready(nxt);
            if constexpr (SP2) {
            PG8_LDB(B0, 0, 0); PG8_LDB(B1, 0, 1); PG8_SCHED; PG8_LDA(At, 0, 0); PG8_STAGE(PG8_SA(1, 1), a1 + hstep, voffA);
            PG8_WAIT_V(8); PG8_WAIT_L(0); PG8_BAR; PG8_MMA(0, 0, At, B0); PG8_MMA(0, 1, At, B1); PG8_BAR; PG8_SCHED;
            PG8_LDA(At, 0, 1); PG8_STAGE(PG8_SB(0, 0), b2, voffB); PG8_STAGE(PG8_SB(0, 1), b2 + hstep, voffB); PG8_STAGE(PG8_SA(0, 0), a2, voffA);
            PG8_WAIT_V(8); PG8_WAIT_L(0); PG8_BAR; PG8_MMA(1, 0, At, B0); PG8_MMA(1, 1, At, B1); PG8_BAR; PG8_SCHED;
            PG8_LDB(B0, 1, 0); PG8_LDB(B1, 1, 1); PG8_SCHED; PG8_LDA(At, 1, 0); PG8_STAGE(PG8_SA(0, 1), a2 + hstep, voffA);
            PG8_WAIT_V(8); PG8_WAIT_L(0); PG8_BAR; PG8_MMA(0, 0, At, B0); PG8_MMA(0, 1, At, B1); PG8_BAR; PG8_SCHED;
            if (last) E.prefetch(pre, cur, wr, fr);
            PG8_LDA(At, 1, 1); PG8_STAGE(PG8_SB(1, 0), b3, voffB); PG8_STAGE(PG8_SB(1, 1), b3 + hstep, voffB); PG8_STAGE(PG8_SA(1, 0), a3, voffA);
            PG8_WAIT_V(8); PG8_WAIT_L(0); PG8_BAR; PG8_MMA(1, 0, At, B0); PG8_MMA(1, 1, At, B1); PG8_BAR; PG8_SCHED;
            } else {
            PG8_LDB(B0, 0, 0); PG8_SCHED; PG8_LDA(At, 0, 0); PG8_STAGE(PG8_SA(1, 1), a1 + hstep, voffA);
            PG8_WAIT_L(8); PG8_BAR; PG8_WAIT_L(0); PG8_MMA(0, 0, At, B0); PG8_BAR; PG8_SCHED;
            PG8_LDB(B1, 0, 1); PG8_STAGE(PG8_SB(0, 0), b2, voffB);
            PG8_BAR; PG8_WAIT_L(0); PG8_MMA(0, 1, At, B1); PG8_BAR;
            PG8_LDA(At, 0, 1); PG8_STAGE(PG8_SA(0, 0), a2, voffA);
            PG8_BAR; PG8_WAIT_L(0); PG8_MMA(1, 0, At, B0); PG8_BAR; PG8_SCHED;
            PG8_STAGE(PG8_SB(0, 1), b2 + hstep, voffB);
            PG8_WAIT_V(6); PG8_BAR; PG8_MMA(1, 1, At, B1); PG8_BAR;
            PG8_LDB(B0, 1, 0); PG8_SCHED; PG8_LDA(At, 1, 0); PG8_STAGE(PG8_SA(0, 1), a2 + hstep, voffA);
            PG8_WAIT_L(8); PG8_BAR; PG8_WAIT_L(0); PG8_MMA(0, 0, At, B0); PG8_BAR; PG8_SCHED;
            PG8_LDB(B1, 1, 1); PG8_STAGE(PG8_SB(1, 0), b3, voffB);
            PG8_BAR; PG8_WAIT_L(0); PG8_MMA(0, 1, At, B1); PG8_BAR;
            PG8_LDA(At, 1, 1); PG8_STAGE(PG8_SA(1, 0), a3, voffA);
            PG8_BAR; PG8_WAIT_L(0); PG8_MMA(1, 0, At, B0); PG8_BAR; PG8_SCHED;
            PG8_STAGE(PG8_SB(1, 1), b3 + hstep, voffB);
            PG8_WAIT_V(6); PG8_BAR; PG8_MMA(1, 1, At, B1); PG8_BAR;
            }
        }
        if constexpr (ALIGN_EPI) { if (wr == 0) PG8_BAR; }
        if constexpr (F8) asm volatile("s_nop 15\n\ts_nop 15" ::: "memory");
        if constexpr (!Epi::AFTER_DRAIN) { E(acc, cur, wr, wc, fr, fq, pre); S.done(cur); }
        if (!has_next) break;
#pragma unroll
        for (int a = 0; a < 2; ++a)
#pragma unroll
            for (int b = 0; b < 2; ++b)
#pragma unroll
                for (int m = 0; m < 4; ++m)
#pragma unroll
                    for (int n = 0; n < 2; ++n) acc[a][b][m][n] = (f32x4){0.f, 0.f, 0.f, 0.f};
        cur = nxt; cA = nA; cB = nB; ++ui;
        if constexpr (ALIGN_EPI) { if (wr == 1) PG8_BAR; }
    }
    PG8_WAIT_V(0);
    if constexpr (!ALIGN_EPI) { if (wr == 0) PG8_BAR; }
    PG8_BAR;
    if constexpr (Epi::AFTER_DRAIN) { E.fused(acc, cur, wr, wc, fr, fq, lds, wid, lane); S.done(cur); }
#undef PG8_SA
#undef PG8_SB
#undef PG8_STAGE
#undef PG8_LDA
#undef PG8_LDB
#undef PG8_MMA
#undef PG8_WAIT_V
#undef PG8_WAIT_L
#undef PG8_BAR
#undef PG8_SCHED
}
}
#define GAS __attribute__((address_space(1)))
#define LAS __attribute__((address_space(3)))
typedef unsigned short bf16;
typedef unsigned v4u __attribute__((ext_vector_type(4)));
typedef float f32x4 __attribute__((ext_vector_type(4)));
typedef short bf16x8 __attribute__((ext_vector_type(8)));
typedef GAS unsigned gu32;
typedef GAS unsigned long long gu64;
#define RLX_AGENT __ATOMIC_RELAXED, __HIP_MEMORY_SCOPE_AGENT
#define LDS_WAIT() asm volatile("s_waitcnt lgkmcnt(0)" ::: "memory")
#define VM_WAIT() asm volatile("s_waitcnt vmcnt(0)" ::: "memory")
__device__ __forceinline__ unsigned long long rt() { return __builtin_amdgcn_s_memrealtime(); }
__device__ __forceinline__ unsigned f2bf(float f) { unsigned u = __builtin_bit_cast(unsigned, f); return (u + 0x7fffu + ((u >> 16) & 1u)) >> 16; }
__device__ __forceinline__ unsigned pk2(float lo, float hi) { return f2bf(lo) | (f2bf(hi) << 16); }
#define XB_TMO      128
#define XB_XCNT(j)  (256  + 64 * (j))
#define XB_XSUB(j)  (1280 + 64 * (j))
#define XB_XGEN(j)  (2304 + 64 * (j))
#define XB_TOP      3328
#define XB_TOPGEN   3392
#define XCD_BAR_WORDS 3456
#define XB_SPIN_CAP (1u << 18)

__device__ __forceinline__ unsigned xb_ld(unsigned* p)              { return __hip_atomic_load(p, __ATOMIC_RELAXED, __HIP_MEMORY_SCOPE_AGENT); }
__device__ __forceinline__ unsigned xb_add(unsigned* p, unsigned v) { return __hip_atomic_fetch_add(p, v, __ATOMIC_RELAXED, __HIP_MEMORY_SCOPE_AGENT); }
__device__ __forceinline__ unsigned xb_xcc_id() { return (unsigned)__builtin_amdgcn_s_getreg((3 << 11) | 20) & 0xFu; }
#define XB_SPIN(cond, bar) do { unsigned _sp = 0; while (cond) { __builtin_amdgcn_s_sleep(1); \
    if ((++_sp & 255u) == 0u) { if (xb_ld(&(bar)[XB_TMO])) break; if (_sp > XB_SPIN_CAP) { atomicAdd(&(bar)[XB_TMO], 1u); break; } } } } while (0)

struct XcdBarrier {
    unsigned* bar; unsigned x;
    volatile LAS unsigned* st;
};

__device__ __forceinline__ XcdBarrier xcd_barrier_post(unsigned* bar, volatile LAS unsigned* st) {
    XcdBarrier b; b.bar = bar; b.x = xb_xcc_id(); b.st = st;
    if (threadIdx.x == 0) st[2] = xb_add(&bar[XB_XCNT(b.x)], 1u);
    return b;
}
__device__ __forceinline__ void xcd_barrier_complete(unsigned* bar, unsigned x, unsigned& nloc, unsigned& nx, unsigned& even) {
    const unsigned G = gridDim.x * gridDim.y * gridDim.z;
    unsigned sum, cnt, mine, sp = 0u, ev;
    for (;;) {
        sum = 0u; cnt = 0u; mine = 0u; ev = 1u;
#pragma unroll
        for (unsigned j = 0; j < 16; ++j) { const unsigned c = xb_ld(&bar[XB_XCNT(j)]); sum += c; cnt += (c > 0u) ? 1u : 0u; mine = (j == x) ? c : mine; ev &= (c == (j < 8u ? G / 8u : 0u)) ? 1u : 0u; }
        if (sum == G) break;
        __builtin_amdgcn_s_sleep(1);
        if ((++sp & 255u) == 0u) { if (xb_ld(&bar[XB_TMO])) break; if (sp > XB_SPIN_CAP) { atomicAdd(&bar[XB_TMO], 1u); break; } }
    }
    nloc = mine > 0u ? mine : 1u; nx = cnt > 0u ? cnt : 1u; even = (sum == G && (G & 7u) == 0u) ? ev : 0u;
}

__device__ __forceinline__ void xcd_barrier(const XcdBarrier& b) {
    asm volatile("s_waitcnt vmcnt(0)" ::: "memory");
    __syncthreads();
    if (threadIdx.x == 0) {
        unsigned* bar = b.bar;
        __builtin_amdgcn_s_waitcnt(0);
        unsigned nloc = b.st[0], nx = b.st[1];
        if (nloc == 0u) { unsigned even; xcd_barrier_complete(bar, b.x, nloc, nx, even); b.st[0] = nloc; b.st[1] = nx; b.st[3] = even; }
        const unsigned old = xb_add(&bar[XB_XSUB(b.x)], 1u);
        const unsigned gen = old / nloc;
        if (old + 1u == (gen + 1u) * nloc) {
            __builtin_amdgcn_fence(__ATOMIC_RELEASE, "agent");
            asm volatile("s_waitcnt vmcnt(0)" ::: "memory");
            const unsigned og = xb_add(&bar[XB_TOP], 1u);
            const unsigned tg = og / nx;
            if (og + 1u == (tg + 1u) * nx) xb_add(&bar[XB_TOPGEN], 1u);
            else XB_SPIN(xb_ld(&bar[XB_TOPGEN]) == tg, bar);
            __builtin_amdgcn_fence(__ATOMIC_ACQUIRE, "agent");
            xb_add(&bar[XB_XGEN(b.x)], 1u);
            asm volatile("s_waitcnt vmcnt(0)" ::: "memory");
        } else {
            XB_SPIN(xb_ld(&bar[XB_XGEN(b.x)]) == gen, bar);
            __builtin_amdgcn_fence(__ATOMIC_ACQUIRE, "agent");
            asm volatile("s_waitcnt vmcnt(0)" ::: "memory");
        }
    }
    __syncthreads();
}

#define XB_LSUB(j) (64 * (int)(j) - 4096)
__device__ __forceinline__ void xcd_barrier_local(const XcdBarrier& b) {
    asm volatile("s_waitcnt vmcnt(0)" ::: "memory");
    __syncthreads();
    if (threadIdx.x == 0) {
        unsigned* bar = b.bar;
        __builtin_amdgcn_s_waitcnt(0);
        const unsigned nloc = b.st[0];
        const unsigned k = b.st[6] + 1u; b.st[6] = k;
        __builtin_amdgcn_fence(__ATOMIC_ACQUIRE, "agent");
        (void)__hip_atomic_fetch_add(&bar[XB_LSUB(b.x)], 1u, __ATOMIC_RELAXED, __HIP_MEMORY_SCOPE_AGENT);
        XB_SPIN(xb_ld(&bar[XB_LSUB(b.x)]) < k * nloc, bar);
        asm volatile("s_waitcnt vmcnt(0)" ::: "memory");
    }
    __syncthreads();
}
constexpr int NWAVES = 8;
#ifndef MK_N_LAUNCHES
#define MK_N_LAUNCHES 1
#endif
constexpr int N_PHASES = 18;
#ifndef PH_ENABLE
#define PH_ENABLE 0x1ff
#endif
#define EN(x) (((PH_ENABLE) >> (x)) & 1)
#ifndef DUP_MASK
#define DUP_MASK 0
#endif
#ifndef TAIL_SPLIT
#define TAIL_SPLIT 1
#endif
#ifndef PROBE_SKIP_EPI
#define PROBE_SKIP_EPI 0
#endif
#define NREP(x) ((((DUP_MASK) >> (x)) & 1) ? 2 : 1)
constexpr int N_LAUNCHES = MK_N_LAUNCHES;

constexpr int BATCH = 16, SEQ = 2048, D = 1024, M = BATCH * SEQ, FF = 2816, NGU = 2 * FF, NPROJ = 3328, PW = pg8::PW, CHUNK = 128, NCH = SEQ / CHUNK, NHEAD = 4;
constexpr float EPS = 1e-6f;
constexpr int TAIL_WGS = M / 256, NSHARE = 256;
constexpr int RET_WGS = BATCH * NHEAD;

constexpr size_t MiB = 1u << 20;
constexpr size_t WS_CTL = 0, CTL_ZERO_BYTES = 32768;
constexpr size_t WS_SSQ = 1 * MiB;
constexpr size_t WS_COS = 2 * MiB, WS_SIN = 2 * MiB + 512 * 1024;
constexpr size_t WS_WTRIL = 3 * MiB;
constexpr size_t WS_W = 4 * MiB;
constexpr size_t W_GU = (size_t)NGU * D * 2, W_DN = (size_t)D * FF * 2, W_IN = (size_t)NPROJ * D * 2, W_OUT = (size_t)D * D * 2;
constexpr size_t WO_GU1 = 0, WO_D1 = WO_GU1 + W_GU, WO_IN = WO_D1 + W_DN, WO_OUT = WO_IN + W_IN, WO_GU2 = WO_OUT + W_OUT, WO_D2 = WO_GU2 + W_GU, W_LAYER = WO_D2 + W_DN;
static_assert(WS_W + 2 * W_LAYER <= 88 * MiB, "weights");
constexpr size_t WS_XB = 88 * MiB;
constexpr size_t WS_HP = 152 * MiB;
constexpr size_t WS_Y = 344 * MiB;
constexpr size_t WS_PT = 408 * MiB;
constexpr size_t WS_X8 = 440 * MiB;
constexpr size_t WS_D1F8 = 472 * MiB;
constexpr size_t WS_END = 476 * MiB;
constexpr int CW_BAR = 4096;
static_assert((CW_BAR + XCD_BAR_WORDS) * 4 <= (int)CTL_ZERO_BYTES && CTL_ZERO_BYTES % 16 == 0, "the barrier words sit inside the per-call memset");

constexpr int RING_OFF = 0, RING_BYTES = 131072;
constexpr int TILE_LD = 272, TILE_BYTES = 128 * TILE_LD;
constexpr int SCR_BYTES = 4 * TILE_BYTES;
constexpr int LDSCTL_OFF = SCR_BYTES, MISC_OFF = LDSCTL_OFF + 320;
constexpr int LDS_BYTES = 147456;
static_assert(MISC_OFF + 128 <= LDS_BYTES && RING_BYTES <= SCR_BYTES, "LDS map");

typedef unsigned short u16x4 __attribute__((ext_vector_type(4)));
typedef unsigned u32x2 __attribute__((ext_vector_type(2)));
#define MFMA16(a, b, c) __builtin_amdgcn_mfma_f32_16x16x32_bf16((a), (b), (c), 0, 0, 0)
typedef short s16x4 __attribute__((ext_vector_type(4)));
template <int LD> __device__ __forceinline__ bf16x8 tr_frag(unsigned addr) {
    const s16x4 lo = __builtin_amdgcn_ds_read_tr16_b64_v4i16((LAS s16x4*)(uintptr_t)addr), hi = __builtin_amdgcn_ds_read_tr16_b64_v4i16((LAS s16x4*)(uintptr_t)(addr + 4 * LD));
    return __builtin_shufflevector(lo, hi, 0, 1, 2, 3, 4, 5, 6, 7);
}
__device__ __forceinline__ float bf2f(unsigned short h) { return __builtin_bit_cast(float, (unsigned)h << 16); }
__device__ __forceinline__ float bflo(unsigned w) { return __builtin_bit_cast(float, w << 16); }
__device__ __forceinline__ float bfhi(unsigned w) { return __builtin_bit_cast(float, w & 0xffff0000u); }
template <int NCOL, int LD> __device__ __forceinline__ void stage_tile(LAS unsigned char* dst, const bf16* src, int gpitch, int tid) {
    constexpr int CPR = NCOL / 8, NCHUNK = 128 * CPR;
#pragma unroll
    for (int i = 0; i < NCHUNK / 512; ++i) { const int c = tid + 512 * i, row = c / CPR, ch = c % CPR;
        const v4u v = *(const GAS v4u*)(src + (size_t)row * gpitch + ch * 8); *(LAS v4u*)(dst + row * LD + ch * 16) = v; }
}
__device__ __forceinline__ float wave_sum(float v) {
#pragma unroll
    for (int o = 1; o < 64; o <<= 1) v += __shfl_xor(v, o);
    return v;
}

struct TrDesc { const float* W; const float* gain; bf16* WT; int N, K, dst_row0, src_col0, k0; float cscale; int f8; };
__device__ __forceinline__ void tr_load(const TrDesc& d, float (&v)[32], int lane) {
    const int n = lane & 31, kh = d.k0 + 32 * (lane >> 5);
    const GAS float* src = (const GAS float*)(d.W + (size_t)kh * d.N + d.src_col0 + n);
#pragma unroll
    for (int i = 0; i < 32; ++i) v[i] = src[(size_t)i * d.N];
}
__device__ __forceinline__ void tr_store(const TrDesc& d, float (&v)[32], int lane) {
    const int n = lane & 31, kh = d.k0 + 32 * (lane >> 5);
    if (d.gain) {
#pragma unroll
        for (int j = 0; j < 8; ++j) { const f32x4 g = *(const GAS f32x4*)(d.gain + kh + 4 * j); v[4 * j] *= g[0]; v[4 * j + 1] *= g[1]; v[4 * j + 2] *= g[2]; v[4 * j + 3] *= g[3]; }
    }
    const float cs = d.cscale;
    if (d.f8) {
        GAS v4u* dst8 = (GAS v4u*)((unsigned char*)d.WT + (size_t)(d.dst_row0 + n) * d.K + kh);
#pragma unroll
        for (int j = 0; j < 2; ++j) { int w[4];
#pragma unroll
            for (int q = 0; q < 4; ++q) { w[q] = 0; w[q] = __builtin_amdgcn_cvt_pk_fp8_f32(v[16 * j + 4 * q] * cs, v[16 * j + 4 * q + 1] * cs, w[q], false); w[q] = __builtin_amdgcn_cvt_pk_fp8_f32(v[16 * j + 4 * q + 2] * cs, v[16 * j + 4 * q + 3] * cs, w[q], true); }
            dst8[j] = (v4u){(unsigned)w[0], (unsigned)w[1], (unsigned)w[2], (unsigned)w[3]}; }
        return;
    }
    GAS v4u* dst = (GAS v4u*)(d.WT + (size_t)(d.dst_row0 + n) * d.K + kh);
#pragma unroll
    for (int j = 0; j < 4; ++j) { v4u o; o.x = pk2(v[8 * j] * cs, v[8 * j + 1] * cs); o.y = pk2(v[8 * j + 2] * cs, v[8 * j + 3] * cs); o.z = pk2(v[8 * j + 4] * cs, v[8 * j + 5] * cs); o.w = pk2(v[8 * j + 6] * cs, v[8 * j + 7] * cs); dst[j] = o; }
}
__device__ __forceinline__ int win_src_col(int pn, int c) {
    switch (pn) {
        case 0: return c;
        case 1: return 256 + 64 * ((c >> 5) & 3) + 32 * (c >> 7);
        case 2: return 512 + c;
        case 3: case 4: return (c < 128 ? 768 : 1024 - 128) + 128 * (pn - 3) + c;
        case 5: case 6: { const int cp = c & 127; return 1280 + 128 * (2 * (pn - 5) + (cp >> 6)) + (c < 128 ? 0 : 64) + (cp & 63); }
        case 7: case 8: { const int cp = c & 127; return 1792 + 128 * (2 * (pn - 7) + (cp >> 6)) + (c < 128 ? 0 : 64) + (cp & 63); }
        case 9: case 10: return 2304 + 256 * (pn - 9) + c;
        default: return 2816 + 256 * (pn - 11) + c;
    }
}

__host__ __device__ __forceinline__ constexpr int inner_ks(int i) { return i < 8 ? 0 : i < 14 ? 1 : i < 18 ? 2 : 3; }
__host__ __device__ __forceinline__ constexpr int inner_tb(int i) { return i < 8 ? i : i < 14 ? i - 8 + 2 : i < 18 ? i - 14 + 4 : i - 18 + 6; }
struct Args { const float* in[18]; float* out; unsigned char* ws; int ph_lo, ph_hi, li, pad; };
typedef Args __attribute__((address_space(4))) CArgs;

__global__ void __launch_bounds__(NWAVES * 64, 2) fwd_kernel(Args args0) {
    extern __shared__ __attribute__((aligned(16))) unsigned char lds_raw[];
    LAS unsigned char* lds = (LAS unsigned char*)lds_raw;
    volatile LAS unsigned* MISC = (volatile LAS unsigned*)(lds + MISC_OFF);
    const int tid = threadIdx.x, wave = __builtin_amdgcn_readfirstlane(tid >> 6);
    const int G = gridDim.x, bid0 = blockIdx.x;
    const unsigned lds_base = (unsigned)(uintptr_t)lds;
    gu32* ctl = (gu32*)(args0.ws + WS_CTL);

    for (int u = tid; u < (LDS_BYTES - LDSCTL_OFF) / 4; u += NWAVES * 64) ((LAS unsigned*)(lds + LDSCTL_OFF))[u] = 0u;
    __syncthreads();
    if (tid == 0) MISC[12] = (unsigned)bid0;
    __syncthreads();
    XcdBarrier bar; bar.bar = (unsigned*)(ctl + CW_BAR); bar.x = 0; bar.st = nullptr;
    if (N_LAUNCHES == 1) bar = xcd_barrier_post((unsigned*)(ctl + CW_BAR), MISC + 8);
    const int lo = args0.ph_lo, hi = args0.ph_hi;
#define IN(k) (lo <= (k) && (k) < hi)
#define LAUNDER() const CArgs* ap_ = (const CArgs*)__builtin_amdgcn_kernarg_segment_ptr(); asm volatile("" : "+s"(ap_));     \
    const CArgs& args = *ap_; unsigned char* const ws = ap_->ws; pg8::ssq_t* const ssqb = (pg8::ssq_t*)(ws + WS_SSQ); bf16* const WTRIL = (bf16*)(ws + WS_WTRIL); unsigned char* const XB8 = ws + WS_X8; bf16* const XB = (bf16*)(ws + WS_XB); \
    bf16* const HP = (bf16*)(ws + WS_HP); bf16* const Y = (bf16*)(ws + WS_Y); bf16* const PT = (bf16*)(ws + WS_PT); (void)ssqb; (void)WTRIL; (void)XB8; (void)XB; (void)HP; (void)Y; (void)PT; (void)args; \
    int bidl_ = __builtin_amdgcn_readfirstlane((int)MISC[12]); asm volatile("" : "+s"(bidl_)); const int bid = bidl_;     \
    unsigned lz_ = 0u; asm volatile("" : "+v"(lz_)); int ptid = wave * 64 + (int)__builtin_amdgcn_mbcnt_hi(~0u, __builtin_amdgcn_mbcnt_lo(~0u, lz_));     const int lane = ptid & 63, l15 = lane & 15, q4 = lane >> 4, tq = l15 >> 2, tp = lane & 3; (void)l15; (void)q4; (void)tq; (void)tp; (void)lane
#ifndef PROBE_XBAR
#define PROBE_XBAR 0
#endif
#ifndef LOCAL_SEAMS
#define LOCAL_SEAMS 1
#endif
#define SEAM(k) do { if (IN(k) && IN((k) + 1)) { \
        if ((k) == 0) { xcd_barrier(bar); if (N_LAUNCHES == 1) { if (tid == 0 && MISC[11]) MISC[12] = MISC[10] * 8u + bar.x; __syncthreads(); } } \
        else if (N_LAUNCHES == 1 && LOCAL_SEAMS && MISC[11]) xcd_barrier_local(bar); else xcd_barrier(bar); \
        if (PROBE_XBAR) { xcd_barrier(bar); xcd_barrier(bar); } } } while (0)

#define OWN_ROW0(bid_) (((bid_) & 7) * (M / 8) + ((bid_) >> 3) * (M / G))
    if (EN(0) && IN(0)) {
            for (int rep = 0; rep < NREP(0); ++rep) { LAUNDER();
        const int gw = bid * NWAVES + wave, NGW = G * NWAVES;
        constexpr int I_GU = (NGU / 32) * (D / 64), I_DN = (D / 32) * (FF / 64), I_IN = (NPROJ / 32) * (D / 64), I_OUT = (D / 32) * (D / 64), I_LAYER = 2 * I_GU + 2 * I_DN + I_IN + I_OUT;
#define TR_DECODE(it_, d_) do { const int l_ = (it_) / I_LAYER; int r_ = (it_) % I_LAYER; unsigned char* WL_ = ws + WS_W + (size_t)l_ * W_LAYER; \
            if ((it_) >= 2 * I_LAYER) { const int kb_ = r_ / (D / 32), rb_ = r_ % (D / 32);                                     \
                d_ = TrDesc{args.in[16], nullptr, (bf16*)(ws + WS_D1F8), D, FF, rb_ * 32, rb_ * 32, kb_ * 64, 0.5f * pg8::WD8_SCALE, 1}; } \
            else if (r_ < 2 * I_GU) { const int f_ = r_ / I_GU; r_ %= I_GU; const int kb_ = r_ / (NGU / 32), rb_ = r_ % (NGU / 32), pn_ = rb_ >> 3, cb_ = rb_ & 7;     \
                d_ = TrDesc{args.in[(f_ ? 14 : 2) + (cb_ >= 4 ? 1 : 0)] + (size_t)l_ * D * FF, args.in[f_ ? 13 : 1] + l_ * D, (bf16*)(WL_ + (f_ ? WO_GU2 : WO_GU1)), FF, D, rb_ * 32, 128 * pn_ + 32 * (cb_ & 3), kb_ * 64, ((pg8::F8GU_MASK >> (2 * l_ + f_)) & 1) ? pg8::WG8_SCALE : 1.f, (pg8::F8GU_MASK >> (2 * l_ + f_)) & 1}; } \
            else if ((r_ -= 2 * I_GU) < 2 * I_DN) { const int f_ = r_ / I_DN; r_ %= I_DN; const int kb_ = r_ / (D / 32), rb_ = r_ % (D / 32);                \
                d_ = TrDesc{args.in[f_ ? 16 : 4] + (size_t)l_ * FF * D, nullptr, (bf16*)(WL_ + (f_ ? WO_D2 : WO_D1)), D, FF, rb_ * 32, rb_ * 32, kb_ * 64, ((pg8::F8_MASK >> (2 * l_ + f_)) & 1) ? 0.5f * pg8::WD8_SCALE : 0.5f, (pg8::F8_MASK >> (2 * l_ + f_)) & 1}; } \
            else if ((r_ -= 2 * I_DN) < I_IN) { const int kb_ = r_ / (NPROJ / 32), rb_ = r_ % (NPROJ / 32), pn_ = rb_ >> 3, c_ = (rb_ & 7) * 32; \
                d_ = TrDesc{args.in[6] + (size_t)l_ * D * NPROJ, args.in[5] + l_ * D, (bf16*)(WL_ + WO_IN), NPROJ, D, rb_ * 32, win_src_col(pn_, c_), kb_ * 64, (pn_ == 7 || pn_ == 8) ? 0.08838834764831845f : 1.f, 0}; } \
            else { r_ -= I_IN; const int kb_ = r_ / (D / 32), rb_ = r_ % (D / 32); \
                d_ = TrDesc{args.in[12] + (size_t)l_ * D * D, nullptr, (bf16*)(WL_ + WO_OUT), D, D, rb_ * 32, rb_ * 32, kb_ * 64, 1.f, 0}; } } while (0)
        constexpr int NITEMS = 2 * I_LAYER + (pg8::F8H_MASK ? I_DN : 0); static_assert(pg8::F8H_MASK == 0 || pg8::F8H_MASK == 2, "the half-e4m3 down GEMM is wired for step 1 only");
        for (int it = gw; it < NITEMS; it += 2 * NGW) {
            TrDesc d0, d1; float v0[32], v1[32]; const bool two = it + NGW < NITEMS;
            TR_DECODE(it, d0); tr_load(d0, v0, lane);
            if (two) { TR_DECODE(it + NGW, d1); tr_load(d1, v1, lane); }
            tr_store(d0, v0, lane);
            if (two) tr_store(d1, v1, lane);
        }
#undef TR_DECODE
        const float* xin = args.in[0];
        for (int m0 = OWN_ROW0(bid) + 4 * wave; m0 < OWN_ROW0(bid) + M / G; m0 += 4 * NWAVES) {
            f32x4 v[4][4];
#pragma unroll
            for (int r = 0; r < 4; ++r) { const GAS f32x4* xr = (const GAS f32x4*)(xin + (size_t)(m0 + r) * D) + lane;
#pragma unroll
                for (int j = 0; j < 4; ++j) v[r][j] = xr[64 * j]; }
#pragma unroll
            for (int r = 0; r < 4; ++r) { float s = 0.f;
#pragma unroll
                for (int j = 0; j < 4; ++j) s += (v[r][j].x * v[r][j].x + v[r][j].y * v[r][j].y) + (v[r][j].z * v[r][j].z + v[r][j].w * v[r][j].w);
                s = wave_sum(s);
                GAS unsigned long long* o8 = (GAS unsigned long long*)(XB + (size_t)(m0 + r) * D) + lane;
#pragma unroll
                for (int j = 0; j < 4; ++j) o8[64 * j] = (unsigned long long)pk2(v[r][j].x, v[r][j].y) | ((unsigned long long)pk2(v[r][j].z, v[r][j].w) << 32);
                if (lane == 0) { __hip_atomic_store(ssqb + m0 + r, pg8::ssq_fix(s), RLX_AGENT); __hip_atomic_store(ssqb + M + m0 + r, (pg8::ssq_t)0, RLX_AGENT); } }
        }
        const int gt = bid * (NWAVES * 64) + ptid, NGT = G * NWAVES * 64;
        for (int i = gt; i < 2 * 4 * 128 * 128; i += NGT) { const int t = (i >> 7) & 127, s = i & 127; WTRIL[i] = (bf16)(s <= t ? f2bf(args.in[8][i]) : 0u); }
    }
        }
    SEAM(0);

    int ph = 1, cur = 0;
#pragma unroll 1
    for (int step = 0; step < 4; ++step) {
        const int l = step >> 1, f = step & 1;
#define WL (ws + WS_W + (size_t)l * W_LAYER)
        if (EN(1) && IN(ph)) {
            for (int rep = 0; rep < NREP(1); ++rep) { LAUNDER();
            if (ptid < 128) __hip_atomic_store(ssqb + (cur ^ 1) * M + OWN_ROW0(bid) + ptid, (pg8::ssq_t)0, RLX_AGENT);
            pg8::StaticOrder S; S.init(M, NGU, G, bid);
            if ((pg8::F8GU_MASK >> step) & 1) {
                pg8::Gemm g{(const bf16*)XB8, (const bf16*)(WL + (f ? WO_GU2 : WO_GU1)), M, NGU, D / 2};
                pg8::EpiSwiglu E{HP, ssqb + cur * M, (PROBE_SKIP_EPI && rep + 1 < NREP(1)) ? 1 : 0, (((pg8::F8_MASK >> step) & 1) ? 1 : ((pg8::F8H_MASK >> step) & 1) ? 2 : 0), 1.0f / (pg8::X8_SCALE * pg8::WG8_SCALE)};
                pg8::gemm_phase<pg8::EpiSwiglu, pg8::StaticOrder, true, true, true>(lds + RING_OFF, g, S, E, ptid);
            } else {
                pg8::Gemm g{XB, (const bf16*)(WL + (f ? WO_GU2 : WO_GU1)), M, NGU, D};
                pg8::EpiSwiglu E{HP, ssqb + cur * M, (PROBE_SKIP_EPI && rep + 1 < NREP(1)) ? 1 : 0, (((pg8::F8_MASK >> step) & 1) ? 1 : ((pg8::F8H_MASK >> step) & 1) ? 2 : 0), 1.0f};
                pg8::gemm_phase<pg8::EpiSwiglu, pg8::StaticOrder, true, true, false>(lds + RING_OFF, g, S, E, ptid);
            }
        }
        }
        SEAM(ph); ++ph;
        if (EN(2) && IN(ph)) {
            for (int rep = 0; rep < NREP(2); ++rep) { LAUNDER();
            pg8::StaticOrder S; S.init(M, D, G, bid);
            if ((pg8::F8H_MASK >> step) & 1) {
                pg8::RoundOrder R0; R0.init(M, D, G, bid); R0.i0 = 0; pg8::RoundOrder R1 = R0; R1.i0 = 1;
                unsigned char* const x8n = (f == 1 && ((pg8::F8GU_MASK >> (step + 1)) & 1)) ? XB8 : nullptr;
                { pg8::Gemm g{HP, (const bf16*)(WL + (f ? WO_D2 : WO_D1)), M, D, FF, pg8::H_PAD16}; pg8::EpiResid E{XB, ssqb + (cur ^ 1) * M, 1.f, x8n};
                  pg8::gemm_phase<pg8::EpiResid, pg8::RoundOrder, true, true, false>(lds + RING_OFF, g, R0, E, ptid); }
                { pg8::Gemm g{(const bf16*)((const unsigned char*)HP + pg8::H8M_A_OFF), (const bf16*)(ws + WS_D1F8), M, D, FF / 2, pg8::H_PAD8}; pg8::EpiResid E{XB, ssqb + (cur ^ 1) * M, 1.0f / (pg8::H8_SCALE * pg8::WD8_SCALE), x8n};
                  pg8::gemm_phase<pg8::EpiResid, pg8::RoundOrder, true, true, true>(lds + RING_OFF, g, R1, E, ptid); }
            } else
            if ((pg8::F8_MASK >> step) & 1) {
                pg8::Gemm g{HP, (const bf16*)(WL + (f ? WO_D2 : WO_D1)), M, D, FF / 2, pg8::H_PAD8};
                pg8::EpiResid E{XB, ssqb + (cur ^ 1) * M, (rep + 1 == NREP(2)) ? 1.0f / (pg8::H8_SCALE * pg8::WD8_SCALE) : 0.f, (f == 1 && ((pg8::F8GU_MASK >> (step + 1)) & 1)) ? XB8 : nullptr};
                pg8::gemm_phase<pg8::EpiResid, pg8::StaticOrder, true, true, true>(lds + RING_OFF, g, S, E, ptid);
            } else {
                pg8::Gemm g{HP, (const bf16*)(WL + (f ? WO_D2 : WO_D1)), M, D, FF, pg8::H_PAD16};
                pg8::EpiResid E{XB, ssqb + (cur ^ 1) * M, (rep + 1 == NREP(2)) ? 1.f : 0.f, (f == 1 && ((pg8::F8GU_MASK >> (step + 1)) & 1)) ? XB8 : nullptr};
                pg8::gemm_phase<pg8::EpiResid, pg8::StaticOrder, true, true, false>(lds + RING_OFF, g, S, E, ptid);
            }
        }
        }
        SEAM(ph); ++ph; cur ^= 1;
        if (f == 0) {
            if (EN(3) && IN(ph)) {
            for (int rep = 0; rep < NREP(3); ++rep) { LAUNDER();
                if (ptid < 128) __hip_atomic_store(ssqb + (cur ^ 1) * M + OWN_ROW0(bid) + ptid, (pg8::ssq_t)0, RLX_AGENT);
                pg8::Gemm g{XB, (const bf16*)(WL + WO_IN), M, NPROJ - 256 * TAIL_SPLIT, D}; pg8::StaticOrder S; S.init(M, NPROJ - 256 * TAIL_SPLIT, G, bid);
                pg8::EpiMix E{HP, ssqb + cur * M, args.in[7] + l * 256};
                pg8::gemm_phase<pg8::EpiMix, pg8::StaticOrder, true, true>(lds + RING_OFF, g, S, E, ptid);
            }
        }
            SEAM(ph); ++ph;
            if (EN(4) && IN(ph)) {
            for (int rep = 0; rep < NREP(4); ++rep) { LAUNDER();
              const int x8 = bid & 7, j8 = bid >> 3;
              if (j8 < RET_WGS / 8) {
                constexpr int RK = 0, RV = TILE_BYTES;
                int bidl = j8; asm volatile("" : "+s"(bidl));
                const int b = 2 * x8 + (bidl >> 2), h = bidl & 3;
                const float Gam = pg8::fexp2(128.f * pg8::log2_decay(h));
                {
                const int dq = wave & 1, vq = wave >> 1;
                f32x4 ST[8];
#pragma unroll
                for (int db = 0; db < 8; ++db) ST[db] = (f32x4){0.f, 0.f, 0.f, 0.f};
                v4u pf[8], pg[8], ph8[8];
#define KV_LOAD(dst_, n_) do { _Pragma("unroll") for (int i = 0; i < 4; ++i) { const int c = ptid + 512 * i, row = c >> 4, ch = c & 15; const bf16* src = HP + pg8::ptile(b * SEQ + (n_) * CHUNK + row, h, 1) + ch * 8; \
                    dst_[i] = *(const GAS v4u*)src; dst_[4 + i] = *(const GAS v4u*)(src + 16384); } } while (0)
                constexpr int NTRIP = (NCH - 1);
                KV_LOAD(pf, 0); KV_LOAD(pg, 1); KV_LOAD(ph8, 2);
#define KV_PUT(buf_, img_) do { _Pragma("unroll") for (int i = 0; i < 4; ++i) { const int c = ptid + 512 * i, row = c >> 4, ch = c & 15; \
                        *(LAS v4u*)(lds + (img_) * 2 * TILE_BYTES + RK + row * TILE_LD + ch * 16) = buf_[i]; *(LAS v4u*)(lds + (img_) * 2 * TILE_BYTES + RV + row * TILE_LD + ch * 16) = buf_[4 + i]; } \
                    asm volatile("" ::: "memory"); } while (0)
                __syncthreads();
                KV_PUT(pf, 0); KV_LOAD(pf, 3);
#define CHAIN_STEP(nbuf_, n_) do { constexpr int n = (n_), img = n & 1; \
                    __syncthreads();                                                 \
                    if (n + 1 < NTRIP) { KV_PUT(nbuf_, img ^ 1); if (n + 4 < NTRIP) KV_LOAD(nbuf_, n + 4); } \
                    const unsigned ib = lds_base + img * 2 * TILE_BYTES; \
                      \
                    bf16x8 ak[2][4], bv[2][2];                                       \
                    _Pragma("unroll") for (int dbl = 0; dbl < 4; ++dbl) ak[0][dbl] = tr_frag<TILE_LD>(ib + RK + (8 * q4 + tq) * TILE_LD + (16 * (4 * dq + dbl) + 4 * tp) * 2); \
                    _Pragma("unroll") for (int vb = 0; vb < 2; ++vb) bv[0][vb] = tr_frag<TILE_LD>(ib + RV + (8 * q4 + tq) * TILE_LD + (16 * (2 * vq + vb) + 4 * tp) * 2); \
                    _Pragma("unroll") for (int ks = 0; ks < 4; ++ks) { \
                        if (ks < 3) { _Pragma("unroll") for (int dbl = 0; dbl < 4; ++dbl) ak[(ks + 1) & 1][dbl] = tr_frag<TILE_LD>(ib + RK + (32 * (ks + 1) + 8 * q4 + tq) * TILE_LD + (16 * (4 * dq + dbl) + 4 * tp) * 2); \
                                      _Pragma("unroll") for (int vb = 0; vb < 2; ++vb) bv[(ks + 1) & 1][vb] = tr_frag<TILE_LD>(ib + RV + (32 * (ks + 1) + 8 * q4 + tq) * TILE_LD + (16 * (2 * vq + vb) + 4 * tp) * 2); } \
                        _Pragma("unroll") for (int dbl = 0; dbl < 4; ++dbl) _Pragma("unroll") for (int vb = 0; vb < 2; ++vb) ST[2 * dbl + vb] = MFMA16(ak[ks & 1][dbl], bv[ks & 1][vb], ST[2 * dbl + vb]); \
                        __builtin_amdgcn_sched_barrier(0); } \
                    bf16* pt = PT + (size_t)((b * NCH + n + 1) * 4 + h) * 16384 + (32 * vq + l15) * 128 + 64 * dq + 4 * q4; \
                    _Pragma("unroll") for (int dbl = 0; dbl < 4; ++dbl) _Pragma("unroll") for (int vb = 0; vb < 2; ++vb) { f32x4& S_ = ST[2 * dbl + vb]; S_ = S_ * Gam; u32x2 o; o.x = pg8::cvt_pk_bf16(S_[0], S_[1]); o.y = pg8::cvt_pk_bf16(S_[2], S_[3]); *(GAS u32x2*)(pt + (16 * vb) * 128 + 16 * dbl) = o; } \
                } while (0)
                static_assert(NTRIP == 15, "the chain is written out step by step");
                CHAIN_STEP(pg, 0); CHAIN_STEP(ph8, 1); CHAIN_STEP(pf, 2); CHAIN_STEP(pg, 3); CHAIN_STEP(ph8, 4); CHAIN_STEP(pf, 5); CHAIN_STEP(pg, 6); CHAIN_STEP(ph8, 7);
                CHAIN_STEP(pf, 8); CHAIN_STEP(pg, 9); CHAIN_STEP(ph8, 10); CHAIN_STEP(pf, 11); CHAIN_STEP(pg, 12); CHAIN_STEP(ph8, 13); CHAIN_STEP(pf, 14);
                __syncthreads(); }
#undef CHAIN_STEP
#undef KV_PUT
#undef KV_LOAD
              } else {
                const int wb = (j8 - RET_WGS / 8) * 8 + x8;
                if (TAIL_SPLIT && wb < TAIL_WGS) {
#pragma unroll 1
                    for (int rep10 = 0; rep10 < NREP(10); ++rep10) { LAUNDER();
                    pg8::Gemm g{XB, (const bf16*)(WL + WO_IN) + (size_t)(NPROJ - 256) * D, M, 256, D}; pg8::StaticOrder S; S.init(M, 256, TAIL_WGS, wb);
                    pg8::EpiSilu E{HP, ssqb + cur * M, 2};
                    pg8::gemm_phase<pg8::EpiSilu, pg8::StaticOrder, true, true>(lds + RING_OFF, g, S, E, ptid);
                    __syncthreads(); }
                }
                const int nsh = wb < TAIL_WGS ? 1 : 2, wsh = 32 * x8 + (wb < TAIL_WGS ? j8 - 8 : 16 + 2 * (j8 - 24));
                for (int rep6 = 0; rep6 < NREP(6); ++rep6) {
                for (int sh = wsh; sh < wsh + nsh; ++sh) {
                    const int R0 = sh * CHUNK, t = 16 * wave + l15, row = R0 + t;
                    constexpr int UOFF = 2 * TILE_BYTES, UL = 528;
                    v4u pv[4][2]; v4u pu[8]; float bsv[4]; v4u pw[4];
#pragma unroll
                    for (int i = 0; i < 8; ++i) { const int c = ptid + 512 * i; pu[i] = *(const GAS v4u*)(HP + pg8::prow_off(R0 + (c >> 5)) + (c & 31) * 8); }
#pragma unroll
                    for (int gq = 0; gq < 4; ++gq) {
#pragma unroll
                        for (int i = 0; i < 2; ++i) { const int c = ptid + 512 * i; pv[gq][i] = *(const GAS v4u*)(HP + pg8::prow_off(R0 + (c >> 3)) + 256 + 64 * gq + (c & 7) * 8); }
                        bsv[gq] = args.in[9][(l * 4 + gq) * 128 + t];
                    }
#define W_LOAD(gq_) do { _Pragma("unroll") for (int i = 0; i < 4; ++i) { const int c = ptid + 512 * i; pw[i] = *(const GAS v4u*)(WTRIL + (size_t)(l * 4 + (gq_)) * 16384 + (c >> 4) * 128 + (c & 15) * 8); } } while (0)
                    W_LOAD(0);
#pragma unroll
                    for (int gq = 0; gq < 4; ++gq) {
                        __syncthreads();
#pragma unroll
                        for (int i = 0; i < 4; ++i) { const int c = ptid + 512 * i; *(LAS v4u*)(lds + (c >> 4) * TILE_LD + (c & 15) * 16) = pw[i]; }
#pragma unroll
                        for (int i = 0; i < 2; ++i) { const int c = ptid + 512 * i; *(LAS v4u*)(lds + TILE_BYTES + (c >> 3) * 144 + (c & 7) * 16) = pv[gq][i]; }
                        if (gq == 0) {
#pragma unroll
                            for (int i = 0; i < 8; ++i) { const int c = ptid + 512 * i; *(LAS v4u*)(lds + UOFF + (c >> 5) * UL + (c & 31) * 16) = pu[i]; } }
                        asm volatile("" ::: "memory");
                        if (gq + 1 < 4) W_LOAD(gq + 1);
                        __syncthreads();
                        f32x4 acc[4];
#pragma unroll
                        for (int db = 0; db < 4; ++db) acc[db] = (f32x4){0.f, 0.f, 0.f, 0.f};
                        const int kmax = wave >> 1;
#pragma unroll
                        for (int ks = 0; ks < 4; ++ks) if (ks <= kmax) {
                            const bf16x8 bw = *(const LAS bf16x8*)(lds + (16 * wave + l15) * TILE_LD + (32 * ks + 8 * q4) * 2);
#pragma unroll
                            for (int db = 0; db < 4; ++db) { const bf16x8 av = tr_frag<144>(lds_base + TILE_BYTES + (32 * ks + 8 * q4 + tq) * 144 + (16 * db + 4 * tp) * 2); acc[db] = MFMA16(av, bw, acc[db]); }
                        }
#pragma unroll
                        for (int db = 0; db < 4; ++db) { const int col = 64 * gq + 16 * db + 4 * q4; const float bb = bsv[gq];
                            LAS u32x2* up = (LAS u32x2*)(lds + UOFF + t * UL + col * 2); const u32x2 uu = *up;
                            u32x2 o; o.x = pg8::cvt_pk_bf16(bflo(uu.x) * (acc[db][0] + bb), bfhi(uu.x) * (acc[db][1] + bb)); o.y = pg8::cvt_pk_bf16(bflo(uu.y) * (acc[db][2] + bb), bfhi(uu.y) * (acc[db][3] + bb));
                            *up = o; }
                    }
                    __syncthreads();
#pragma unroll
                    for (int i = 0; i < 8; ++i) { const int c = ptid + 512 * i; *(GAS v4u*)(Y + (size_t)(R0 + (c >> 5)) * D + (c & 31) * 8) = *(const LAS v4u*)(lds + UOFF + (c >> 5) * UL + (c & 31) * 16); }
#undef W_LOAD
                }
                __syncthreads();
                for (int sh = wsh; sh < wsh + nsh; ++sh) { const int it = sh * 512 + ptid;
                    const int rb = it >> 5, c8 = (it & 31) * 8, row0 = rb * 8; const float* cw = args.in[10] + l * 768 + c8;
                    float w0[8], w1[8], w2[8], z2[8], z1[8];
#pragma unroll
                    for (int j = 0; j < 8; ++j) { w0[j] = cw[j]; w1[j] = cw[256 + j]; w2[j] = cw[512 + j]; z2[j] = 0.f; z1[j] = 0.f; }
                    if ((row0 & (SEQ - 1)) != 0) {
                        const v4u a = *(const GAS v4u*)(HP + pg8::prow_off(row0 - 2) + 768 + c8), b = *(const GAS v4u*)(HP + pg8::prow_off(row0 - 1) + 768 + c8);
                        z2[0] = bflo(a.x); z2[1] = bfhi(a.x); z2[2] = bflo(a.y); z2[3] = bfhi(a.y); z2[4] = bflo(a.z); z2[5] = bfhi(a.z); z2[6] = bflo(a.w); z2[7] = bfhi(a.w);
                        z1[0] = bflo(b.x); z1[1] = bfhi(b.x); z1[2] = bflo(b.y); z1[3] = bfhi(b.y); z1[4] = bflo(b.z); z1[5] = bfhi(b.z); z1[6] = bflo(b.w); z1[7] = bfhi(b.w);
                    }
                    v4u zcv[8], bgv[8];
#pragma unroll
                    for (int j = 0; j < 8; ++j) { zcv[j] = *(const GAS v4u*)(HP + pg8::prow_off(row0 + j) + 768 + c8); bgv[j] = *(const GAS v4u*)(HP + pg8::prow_off(row0 + j) + 512 + c8); }
#pragma unroll
                    for (int j = 0; j < 8; ++j) {
                        const v4u zc = zcv[j], bg = bgv[j];
                        float z0[8], g8[8], y[8];
                        z0[0] = bflo(zc.x); z0[1] = bfhi(zc.x); z0[2] = bflo(zc.y); z0[3] = bfhi(zc.y); z0[4] = bflo(zc.z); z0[5] = bfhi(zc.z); z0[6] = bflo(zc.w); z0[7] = bfhi(zc.w);
                        g8[0] = bflo(bg.x); g8[1] = bfhi(bg.x); g8[2] = bflo(bg.y); g8[3] = bfhi(bg.y); g8[4] = bflo(bg.z); g8[5] = bfhi(bg.z); g8[6] = bflo(bg.w); g8[7] = bfhi(bg.w);
#pragma unroll
                        for (int k = 0; k < 8; ++k) { y[k] = g8[k] * (w0[k] * z2[k] + w1[k] * z1[k] + w2[k] * z0[k]); z2[k] = z1[k]; z1[k] = z0[k]; }
                        v4u o; o.x = pg8::cvt_pk_bf16(y[0], y[1]); o.y = pg8::cvt_pk_bf16(y[2], y[3]); o.z = pg8::cvt_pk_bf16(y[4], y[5]); o.w = pg8::cvt_pk_bf16(y[6], y[7]);
                        *(GAS v4u*)(Y + (size_t)(row0 + j) * D + 256 + c8) = o;
                    }
                }
                }
              }
            }
        }
            SEAM(ph); ++ph;
            if (EN(5) && IN(ph)) {
            for (int rep = 0; rep < NREP(5); ++rep) { LAUNDER();
                constexpr int RQ = 0, RK = TILE_BYTES, RV = 2 * TILE_BYTES, RS = 3 * TILE_BYTES, RPST = 0, RSTT = 8192;
                v4u pf[12];
#define RET_LOAD(un_) do { const int h_ = (un_) & 3, bn_ = (un_) >> 2; _Pragma("unroll") for (int i = 0; i < 4; ++i) { const int c = ptid + 512 * i, row = c >> 4, ch = c & 15; const bf16* src = HP + pg8::ptile(bn_ * CHUNK + row, h_, 0) + ch * 8; \
                    pf[i] = *(const GAS v4u*)src; pf[4 + i] = *(const GAS v4u*)(src + 16384); pf[8 + i] = *(const GAS v4u*)(src + 2 * 16384); } } while (0)
                const int un0 = 128 * (bid & 7) + (bid >> 3), un1 = 128 * (bid & 7) + 128;
                RET_LOAD(un0);
                v4u pan[4];
#pragma unroll
                for (int ks = 0; ks < 4; ++ks) pan[ks] = *(const GAS v4u*)(PT + (size_t)un0 * 16384 + (16 * wave + l15) * 128 + 32 * ks + 8 * q4);
#pragma unroll 1
                for (int un = un0; un < un1; un += G / 8) {
                    const int h = un & 3, bn = un >> 2, n = bn & (NCH - 1);
                    const int vcol = 128 * h + 16 * wave + 4 * q4;
                    __syncthreads();
#pragma unroll
                    for (int i = 0; i < 4; ++i) { const int c = ptid + 512 * i, row = c >> 4, ch = c & 15;
                        *(LAS v4u*)(lds + RQ + row * TILE_LD + ch * 16) = pf[i]; *(LAS v4u*)(lds + RK + row * TILE_LD + ch * 16) = pf[4 + i]; *(LAS v4u*)(lds + RV + row * TILE_LD + ch * 16) = pf[8 + i]; }
                    asm volatile("" ::: "memory");
                    v4u pgc[4];
#pragma unroll
                    for (int i = 0; i < 4; ++i) { const int c = ptid + 512 * i; pgc[i] = *(const GAS v4u*)(HP + pg8::ptile(bn * CHUNK + (c >> 4), h, 3) + (c & 15) * 8); }
                    v4u pa[4];
#pragma unroll
                    for (int ks = 0; ks < 4; ++ks) pa[ks] = pan[ks];
                    if (un + G / 8 < un1) { RET_LOAD(un + G / 8);
#pragma unroll
                        for (int ks = 0; ks < 4; ++ks) pan[ks] = *(const GAS v4u*)(PT + (size_t)(un + G / 8) * 16384 + (16 * wave + l15) * 128 + 32 * ks + 8 * q4); }
                    __syncthreads();
                    { int idx = 0;
#pragma unroll
                      for (int tb = 0; tb < 8; ++tb) {
#pragma unroll
                        for (int cb = 0; cb <= tb; ++cb) {
                            if ((idx & 7) == wave) {
                                f32x4 sa = (f32x4){0.f, 0.f, 0.f, 0.f};
                                bf16x8 ak[4], bq[4];
#pragma unroll
                                for (int ks = 0; ks < 4; ++ks) { ak[ks] = *(const LAS bf16x8*)(lds + RK + (16 * cb + l15) * TILE_LD + (32 * ks + 8 * q4) * 2); bq[ks] = *(const LAS bf16x8*)(lds + RQ + (16 * tb + l15) * TILE_LD + (32 * ks + 8 * q4) * 2); }
#pragma unroll
                                for (int ks = 0; ks < 4; ++ks) sa = MFMA16(ak[ks], bq[ks], sa);
                                if (cb == tb) {
#pragma unroll
                                    for (int e = 0; e < 4; ++e) if (4 * q4 + e > l15) sa[e] = 0.f; }
                                u32x2 o; o.x = pg8::cvt_pk_bf16(sa[0], sa[1]); o.y = pg8::cvt_pk_bf16(sa[2], sa[3]);
                                *(LAS u32x2*)(lds + RS + (16 * tb + l15) * TILE_LD + (16 * cb + 4 * q4) * 2) = o;
                            }
                            ++idx;
                        }
                        if ((tb & 1) == 0 && wave == 4 + (tb >> 1)) *(LAS u32x2*)(lds + RS + (16 * tb + l15) * TILE_LD + (16 * (tb + 1) + 4 * q4) * 2) = (u32x2){(unsigned)ptid >> 31, (unsigned)ptid >> 31};
                      } }
                    f32x4 RT[8];
#pragma unroll
                    for (int tb = 0; tb < 8; ++tb) RT[tb] = (f32x4){0.f, 0.f, 0.f, 0.f};
                    if (n > 0) {
                        bf16x8 bq[8];
#pragma unroll
                        for (int tb = 0; tb < 8; ++tb) bq[tb] = *(const LAS bf16x8*)(lds + RQ + (16 * tb + l15) * TILE_LD + (8 * q4) * 2);
#pragma unroll
                        for (int ks = 0; ks < 4; ++ks) {
                            const bf16x8 af = __builtin_bit_cast(bf16x8, pa[ks]);
#pragma unroll
                            for (int tb = 0; tb < 8; ++tb) { RT[tb] = MFMA16(af, bq[tb], RT[tb]);
                                if (ks < 3) bq[tb] = *(const LAS bf16x8*)(lds + RQ + (16 * tb + l15) * TILE_LD + (32 * (ks + 1) + 8 * q4) * 2);
                                __builtin_amdgcn_sched_barrier(0); }
                        }
                    }
                    __syncthreads();
#pragma unroll
                    for (int i = 0; i < 4; ++i) { const int c = ptid + 512 * i; *(LAS v4u*)(lds + RK + (c >> 4) * TILE_LD + (c & 15) * 16) = pgc[i]; }
                    bf16x8 av[4];
#pragma unroll
                    for (int ks = 0; ks < 4; ++ks) av[ks] = tr_frag<TILE_LD>(lds_base + RV + (32 * ks + 8 * q4 + tq) * TILE_LD + (16 * wave + 4 * tp) * 2);
                    { bf16x8 bs[6];
#pragma unroll
                      for (int i = 0; i < 6; ++i) bs[i] = *(const LAS bf16x8*)(lds + RS + (16 * inner_tb(i) + l15) * TILE_LD + (32 * inner_ks(i) + 8 * q4) * 2);
#pragma unroll
                      for (int i = 0; i < 20; ++i) { RT[inner_tb(i)] = MFMA16(av[inner_ks(i)], bs[i % 6], RT[inner_tb(i)]);
                          if (i + 6 < 20) bs[i % 6] = *(const LAS bf16x8*)(lds + RS + (16 * inner_tb(i + 6) + l15) * TILE_LD + (32 * inner_ks(i + 6) + 8 * q4) * 2);
                          __builtin_amdgcn_sched_barrier(0); } }
#pragma unroll
                    for (int tb = 0; tb < 8; ++tb) {
                        float p1 = (RT[tb][0] + RT[tb][1]) + (RT[tb][2] + RT[tb][3]), p2 = (RT[tb][0] * RT[tb][0] + RT[tb][1] * RT[tb][1]) + (RT[tb][2] * RT[tb][2] + RT[tb][3] * RT[tb][3]);
                        p1 += __shfl_xor(p1, 16); p1 += __shfl_xor(p1, 32); p2 += __shfl_xor(p2, 16); p2 += __shfl_xor(p2, 32);
                        if (q4 == 0) *(LAS pg8::f32x2*)(lds + RPST + (wave * 128 + 16 * tb + l15) * 8) = (pg8::f32x2){p1, p2};
                    }
                    __syncthreads();
                    if (ptid < 128) {
                        float s1 = 0.f, s2 = 0.f;
#pragma unroll
                        for (int w8 = 0; w8 < 8; ++w8) { const pg8::f32x2 p = *(const LAS pg8::f32x2*)(lds + RPST + (w8 * 128 + ptid) * 8); s1 += p.x; s2 += p.y; }
                        const float mu = s1 * (1.0f / 128.0f), var = fmaxf(s2 * (1.0f / 128.0f) - mu * mu, 0.f);
                        *(LAS pg8::f32x2*)(lds + RSTT + ptid * 8) = (pg8::f32x2){mu, __builtin_amdgcn_rsqf(var + EPS)};
                    }
                    __syncthreads();
                    const f32x4 gv = *(const GAS f32x4*)(args.in[11] + l * 512 + vcol);
#pragma unroll
                    for (int tb = 0; tb < 8; ++tb) {
                        const pg8::f32x2 st = *(const LAS pg8::f32x2*)(lds + RSTT + (16 * tb + l15) * 8);
                        const u32x2 gg = *(const LAS u32x2*)(lds + RK + (16 * tb + l15) * TILE_LD + (16 * wave + 4 * q4) * 2);
                        u32x2 o; o.x = pg8::cvt_pk_bf16((RT[tb][0] - st.x) * st.y * gv[0] * bflo(gg.x), (RT[tb][1] - st.x) * st.y * gv[1] * bfhi(gg.x));
                        o.y = pg8::cvt_pk_bf16((RT[tb][2] - st.x) * st.y * gv[2] * bflo(gg.y), (RT[tb][3] - st.x) * st.y * gv[3] * bfhi(gg.y));
                        *(LAS u32x2*)(lds + RS + (16 * tb + l15) * TILE_LD + (16 * wave + 4 * q4) * 2) = o;
                    }
                    __syncthreads();
#pragma unroll
                    for (int i = 0; i < 4; ++i) { const int c = ptid + 512 * i, row = c >> 4, ch = c & 15;
                        *(GAS v4u*)(Y + (size_t)(bn * CHUNK + row) * D + 512 + 128 * h + ch * 8) = *(const LAS v4u*)(lds + RS + row * TILE_LD + ch * 16); }
                }
#undef RET_LOAD
            }
        }
            SEAM(ph); ++ph;
            if (EN(7) && IN(ph)) {
            for (int rep = 0; rep < NREP(7); ++rep) { LAUNDER();
                pg8::Gemm g{Y, (const bf16*)(WL + WO_OUT), M, D, D}; pg8::StaticOrder S; S.init(M, D, G, bid);
                pg8::EpiResid E{XB, ssqb + (cur ^ 1) * M, (rep + 1 == NREP(7)) ? 1.f : 0.f, ((pg8::F8GU_MASK >> (step + 1)) & 1) ? XB8 : nullptr};
                pg8::gemm_phase<pg8::EpiResid, pg8::StaticOrder, true, true>(lds + RING_OFF, g, S, E, ptid);
            }
        }
            SEAM(ph); ++ph; cur ^= 1;
        }
    }
    if (EN(8) && IN(ph)) {
        LAUNDER();
        const float* fg = args.in[17]; float* out = args.out;
        f32x4 gv[4];
#pragma unroll
        for (int q = 0; q < 4; ++q) gv[q] = *(const GAS f32x4*)(fg + 4 * lane + 256 * q);
        for (int m0 = OWN_ROW0(bid) + 4 * wave; m0 < OWN_ROW0(bid) + M / G; m0 += 4 * NWAVES) {
            u32x2 w[4][4];
#pragma unroll
            for (int r = 0; r < 4; ++r)
#pragma unroll
                for (int q = 0; q < 4; ++q) w[r][q] = *(const GAS u32x2*)(XB + (size_t)(m0 + r) * D + 4 * lane + 256 * q);
#pragma unroll
            for (int r = 0; r < 4; ++r) {
                f32x4 v[4]; float s = 0.f;
#pragma unroll
                for (int q = 0; q < 4; ++q) { v[q] = (f32x4){bflo(w[r][q].x), bfhi(w[r][q].x), bflo(w[r][q].y), bfhi(w[r][q].y)}; s += (v[q].x * v[q].x + v[q].y * v[q].y) + (v[q].z * v[q].z + v[q].w * v[q].w); }
                const float rstd = __builtin_amdgcn_rsqf(wave_sum(s) * (1.0f / D) + EPS);
#pragma unroll
                for (int q = 0; q < 4; ++q) *(GAS f32x4*)(out + (size_t)(m0 + r) * D + 4 * lane + 256 * q) = v[q] * rstd * gv[q];
            }
        }
    }
#undef WL
#undef IN
#undef SEAM
}

extern "C" void kernel_launch(void* const* d_in, const int* in_sizes, int n_in, void* d_out, int out_size, void* d_ws, size_t ws_size, hipStream_t stream) {
    static int grid = 0;
    if (grid == 0) {
        if (n_in != 18 || in_sizes[0] != M * D || out_size != M * D || ws_size < WS_END) { fprintf(stderr, "kernel_launch: shape/workspace mismatch (n_in %d, in0 %d, out %d, ws %zu); nothing launched\n", n_in, n_in > 0 ? in_sizes[0] : -1, out_size, ws_size); grid = -1; return; }
        int dev = 0, cus = 0, per_cu = 0;
        if (hipGetDevice(&dev) != hipSuccess || hipDeviceGetAttribute(&cus, hipDeviceAttributeMultiprocessorCount, dev) != hipSuccess) { grid = -1; return; }
        if (hipFuncSetAttribute((const void*)fwd_kernel, hipFuncAttributeMaxDynamicSharedMemorySize, LDS_BYTES) != hipSuccess) { fprintf(stderr, "kernel_launch: hipFuncSetAttribute failed\n"); grid = -1; return; }
        if (hipOccupancyMaxActiveBlocksPerMultiprocessor(&per_cu, (const void*)fwd_kernel, NWAVES * 64, LDS_BYTES) != hipSuccess || per_cu < 1)
            fprintf(stderr, "kernel_launch: note: occupancy query reports %d workgroups per CU\n", per_cu);
        (void)hipGetLastError();
        grid = cus;
    }
    if (grid < 0) return;
    if (hipMemsetAsync((char*)d_ws + WS_CTL, 0, CTL_ZERO_BYTES, stream) != hipSuccess) return;
    Args a{};
    for (int i = 0; i < 18; ++i) a.in[i] = (const float*)d_in[i];
    a.out = (float*)d_out; a.ws = (unsigned char*)d_ws;
    for (int li = 0; li < N_LAUNCHES; ++li) {
        a.ph_lo = (N_LAUNCHES == 1) ? 0 : li; a.ph_hi = (N_LAUNCHES == 1) ? N_PHASES : li + 1; a.li = li; a.pad = 0;
        hipLaunchKernelGGL(fwd_kernel, dim3(grid), dim3(NWAVES * 64), LDS_BYTES, stream, a);
        const hipError_t le = hipPeekAtLastError();
        if (le != hipSuccess) { fprintf(stderr, "kernel_launch: launch %d failed: %s\n", li, hipGetErrorName(le)); break; }
    }
}
```
